# Optimizing an MI355X kernel written in HIP

```python
import math
import jax, jax.numpy as jnp
from jax import lax
import numpy as np

D_MODEL = 2048
BATCH = 16
SEQ = 2048
DEPTH = 4

MEM_LEN = 256
N_HEADS_TOTAL = 16
HEAD_DIM = D_MODEL // N_HEADS_TOTAL
N_DIFF = 4
N_SB = 6
N_FOX = N_HEADS_TOTAL - N_DIFF - N_SB
MIX_WIDTH = N_HEADS_TOTAL * HEAD_DIM
DIFF_QK_DIM = HEAD_DIM // 2
A_W = N_DIFF * HEAD_DIM
SB_W = N_SB * HEAD_DIM
FOX_W = N_FOX * HEAD_DIM
IN_COLS = 3 * A_W + 3 * SB_W + 3 * FOX_W + N_FOX
N_CROSS_HEADS = 4
CROSS_HEAD_DIM = D_MODEL // 16
CROSS_W = N_CROSS_HEADS * CROSS_HEAD_DIM
D_FF = -(-8 * D_MODEL // (3 * 256)) * 256
BLOCK_Q = 128
ROPE_THETA = 10000.0
EPS = 1e-6
NEG_INF = -1e30

kernel_name = "hymba_diff_stickbreak_fox_trunk"


def rms_norm(x, g):
    xf = x.astype(jnp.float32)
    y = xf * lax.rsqrt(jnp.mean(xf * xf, axis=-1, keepdims=True) + EPS)
    return (y * g.astype(jnp.float32)).astype(x.dtype)


def rope(x, positions):
    d = x.shape[-1]
    half = d // 2
    inv_freq = ROPE_THETA ** (-jnp.arange(half, dtype=jnp.float32) / half)
    ang = positions.astype(jnp.float32)[..., None] * inv_freq
    cos = jnp.cos(ang)[:, :, None, :]
    sin = jnp.sin(ang)[:, :, None, :]
    x1 = x[..., :half].astype(jnp.float32)
    x2 = x[..., half:].astype(jnp.float32)
    out = jnp.concatenate([x1 * cos - x2 * sin, x2 * cos + x1 * sin], axis=-1)
    return out.astype(x.dtype)


def split_heads(t, n, d):
    b, s, _ = t.shape
    return t.reshape(b, s, n, d).transpose(0, 2, 1, 3)


def merge_heads(t):
    b, h, s, d = t.shape
    return t.transpose(0, 2, 1, 3).reshape(b, s, h * d)


def block_size(s):
    return math.gcd(s, BLOCK_Q)


def to_blocks(t, bq):
    b, h, s = t.shape[:3]
    rest = t.shape[3:]
    t = t.reshape((b, h, s // bq, bq) + rest)
    return jnp.moveaxis(t, 2, 0)


def from_blocks(t):
    nb, b, h, bq, d = t.shape
    return t.transpose(1, 2, 0, 3, 4).reshape(b, h, nb * bq, d)


def query_block_index(s, bq):
    return jnp.arange(s, dtype=jnp.int32).reshape(s // bq, bq)


def diff_attention(q1, q2, k1, k2, v, lam):
    s = q1.shape[2]
    bq = block_size(s)
    scale = DIFF_QK_DIM ** -0.5
    k_idx = jnp.arange(s, dtype=jnp.int32)

    def one_block(args):
        qa, qb, qi = args
        causal = qi[:, None] >= k_idx[None, :]
        s1 = jnp.einsum('bhqd,bhkd->bhqk', qa, k1).astype(jnp.float32) * scale
        s2 = jnp.einsum('bhqd,bhkd->bhqk', qb, k2).astype(jnp.float32) * scale
        p1 = jax.nn.softmax(jnp.where(causal, s1, NEG_INF), axis=-1)
        p2 = jax.nn.softmax(jnp.where(causal, s2, NEG_INF), axis=-1)
        w = p1 - lam * p2
        return jnp.einsum('bhqk,bhkd->bhqd', w.astype(v.dtype), v)

    out = lax.map(one_block, (to_blocks(q1, bq), to_blocks(q2, bq), query_block_index(s, bq)))
    return from_blocks(out)


def stick_breaking_attention(q, k, v):
    s = q.shape[2]
    bq = block_size(s)
    scale = HEAD_DIM ** -0.5
    k_idx = jnp.arange(s, dtype=jnp.int32)

    def one_block(args):
        qb, qi = args
        z = jnp.einsum('bhqd,bhkd->bhqk', qb, k).astype(jnp.float32) * scale
        strict = qi[:, None] > k_idx[None, :]
        log_remain = jnp.where(strict, jax.nn.log_sigmoid(-z), 0.0)
        after = lax.cumsum(log_remain, axis=3, reverse=True) - log_remain
        w = jnp.where(strict, jnp.exp(jax.nn.log_sigmoid(z) + after), 0.0)
        return jnp.einsum('bhqk,bhkd->bhqd', w.astype(v.dtype), v)

    out = lax.map(one_block, (to_blocks(q, bq), query_block_index(s, bq)))
    return from_blocks(out)


def forgetting_attention(q, k, v, log_f):
    s = q.shape[2]
    bq = block_size(s)
    scale = HEAD_DIM ** -0.5
    k_idx = jnp.arange(s, dtype=jnp.int32)
    cum = lax.cumsum(log_f, axis=2)

    def one_block(args):
        qb, cq, qi = args
        logits = jnp.einsum('bhqd,bhkd->bhqk', qb, k).astype(jnp.float32) * scale
        logits = logits + (cq[:, :, :, None] - cum[:, :, None, :])
        causal = qi[:, None] >= k_idx[None, :]
        p = jax.nn.softmax(jnp.where(causal, logits, NEG_INF), axis=-1)
        return jnp.einsum('bhqk,bhkd->bhqd', p.astype(v.dtype), v)

    out = lax.map(one_block, (to_blocks(q, bq), to_blocks(cum, bq), query_block_index(s, bq)))
    return from_blocks(out)


def hybrid_mixer(h, positions, layer_idx, w_in, b_f, lam_q1, lam_k1, lam_q2, lam_k2,
                 g_diff_sub, g_sb_out, g_fox_out, w_out):
    b, s, _ = h.shape
    proj = h @ w_in
    sizes = [A_W, A_W, A_W, SB_W, SB_W, SB_W, FOX_W, FOX_W, FOX_W]
    points = [int(p) for p in np.cumsum(sizes)]
    qa, ka, va, qb, kb, vb, qc, kc, vc, fc = jnp.split(proj, points, axis=-1)

    qa = rope(qa.reshape(b, s, 2 * N_DIFF, DIFF_QK_DIM), positions).reshape(b, s, N_DIFF, 2, DIFF_QK_DIM)
    ka = rope(ka.reshape(b, s, 2 * N_DIFF, DIFF_QK_DIM), positions).reshape(b, s, N_DIFF, 2, DIFF_QK_DIM)
    q1 = qa[:, :, :, 0, :].transpose(0, 2, 1, 3)
    q2 = qa[:, :, :, 1, :].transpose(0, 2, 1, 3)
    k1 = ka[:, :, :, 0, :].transpose(0, 2, 1, 3)
    k2 = ka[:, :, :, 1, :].transpose(0, 2, 1, 3)
    lam_init = 0.8 - 0.6 * math.exp(-0.3 * layer_idx)
    lam = (jnp.exp(jnp.sum(lam_q1.astype(jnp.float32) * lam_k1.astype(jnp.float32)))
           - jnp.exp(jnp.sum(lam_q2.astype(jnp.float32) * lam_k2.astype(jnp.float32)))) + lam_init
    oa = diff_attention(q1, q2, k1, k2, split_heads(va, N_DIFF, HEAD_DIM), lam)
    oa = merge_heads(rms_norm(oa, g_diff_sub) * (1.0 - lam_init))

    ob = stick_breaking_attention(split_heads(qb, N_SB, HEAD_DIM), split_heads(kb, N_SB, HEAD_DIM),
                                  split_heads(vb, N_SB, HEAD_DIM))
    ob = rms_norm(merge_heads(ob), g_sb_out)

    log_f = jax.nn.log_sigmoid((fc + b_f).astype(jnp.float32)).transpose(0, 2, 1)
    oc = forgetting_attention(split_heads(qc, N_FOX, HEAD_DIM), split_heads(kc, N_FOX, HEAD_DIM),
                              split_heads(vc, N_FOX, HEAD_DIM), log_f)
    oc = rms_norm(merge_heads(oc), g_fox_out)

    merged = jnp.concatenate([oa, ob, oc], axis=-1)
    return merged @ w_out


def memory_cross_attention(h, mem_n, w_cq, w_ckv, w_co):
    b, s, _ = h.shape
    m = mem_n.shape[1]
    q = (h @ w_cq).reshape(b, s, N_CROSS_HEADS, CROSS_HEAD_DIM)
    kv = mem_n @ w_ckv
    k = kv[:, :, :CROSS_W].reshape(b, m, N_CROSS_HEADS, CROSS_HEAD_DIM)
    v = kv[:, :, CROSS_W:].reshape(b, m, N_CROSS_HEADS, CROSS_HEAD_DIM)
    logits = jnp.einsum('bqhd,bmhd->bhqm', q, k).astype(jnp.float32) * CROSS_HEAD_DIM ** -0.5
    p = jax.nn.softmax(logits, axis=-1)
    o = jnp.einsum('bhqm,bmhd->bqhd', p.astype(v.dtype), v).reshape(b, s, CROSS_W)
    return o @ w_co


def swiglu(h, w_gate, w_up, w_down):
    return (jax.nn.silu(h @ w_gate) * (h @ w_up)) @ w_down


def setup_inputs(seed: int = 0) -> dict:
    key = jax.random.key(seed)
    ks = jax.random.split(key, 32)
    f32 = jnp.float32

    def dense(k, shape, fan_in):
        return jax.random.normal(k, shape, f32) * fan_in ** -0.5

    def gain(k, shape):
        return 1.0 + 0.05 * jax.random.normal(k, shape, f32)

    x = jax.random.normal(ks[0], (BATCH, SEQ, D_MODEL), f32)
    mem = jax.random.normal(ks[1], (BATCH, MEM_LEN, D_MODEL), f32)
    offsets = jax.random.randint(ks[2], (BATCH, 1), 0, SEQ, dtype=jnp.int32)
    positions = offsets + jnp.arange(SEQ, dtype=jnp.int32)[None, :]
    return {
        "x": x,
        "mem": mem,
        "positions": positions,
        "g_mix_pre": gain(ks[3], (DEPTH, D_MODEL)),
        "g_mix_post": gain(ks[4], (DEPTH, D_MODEL)),
        "w_in": dense(ks[5], (DEPTH, D_MODEL, IN_COLS), D_MODEL),
        "b_f": 2.0 + 0.5 * jax.random.normal(ks[6], (DEPTH, N_FOX), f32),
        "lam_q1": 0.1 * jax.random.normal(ks[7], (DEPTH, DIFF_QK_DIM), f32),
        "lam_k1": 0.1 * jax.random.normal(ks[8], (DEPTH, DIFF_QK_DIM), f32),
        "lam_q2": 0.1 * jax.random.normal(ks[9], (DEPTH, DIFF_QK_DIM), f32),
        "lam_k2": 0.1 * jax.random.normal(ks[10], (DEPTH, DIFF_QK_DIM), f32),
        "g_diff_sub": gain(ks[11], (DEPTH, HEAD_DIM)),
        "g_sb_out": gain(ks[12], (DEPTH, SB_W)),
        "g_fox_out": gain(ks[13], (DEPTH, FOX_W)),
        "w_out": dense(ks[14], (DEPTH, MIX_WIDTH, D_MODEL), MIX_WIDTH),
        "g_x_pre": gain(ks[15], (DEPTH, D_MODEL)),
        "g_x_post": gain(ks[16], (DEPTH, D_MODEL)),
        "g_mem": gain(ks[17], (DEPTH, D_MODEL)),
        "w_cq": dense(ks[18], (DEPTH, D_MODEL, CROSS_W), D_MODEL),
        "w_ckv": dense(ks[19], (DEPTH, D_MODEL, 2 * CROSS_W), D_MODEL),
        "w_co": dense(ks[20], (DEPTH, CROSS_W, D_MODEL), CROSS_W),
        "g_ffn_pre": gain(ks[21], (DEPTH, D_MODEL)),
        "g_ffn_post": gain(ks[22], (DEPTH, D_MODEL)),
        "w_gate": dense(ks[23], (DEPTH, D_MODEL, D_FF), D_MODEL),
        "w_up": dense(ks[24], (DEPTH, D_MODEL, D_FF), D_MODEL),
        "w_down": dense(ks[25], (DEPTH, D_FF, D_MODEL), D_FF),
    }


def reference(x, mem, positions, g_mix_pre, g_mix_post, w_in, b_f, lam_q1, lam_k1, lam_q2, lam_k2,
              g_diff_sub, g_sb_out, g_fox_out, w_out, g_x_pre, g_x_post, g_mem, w_cq, w_ckv, w_co,
              g_ffn_pre, g_ffn_post, w_gate, w_up, w_down):
    for l in range(DEPTH):
        h = rms_norm(x, g_mix_pre[l])
        y = hybrid_mixer(h, positions, l, w_in[l], b_f[l], lam_q1[l], lam_k1[l], lam_q2[l], lam_k2[l],
                         g_diff_sub[l], g_sb_out[l], g_fox_out[l], w_out[l])
        x = x + rms_norm(y, g_mix_post[l])
        h = rms_norm(x, g_x_pre[l])
        mem_n = rms_norm(mem, g_mem[l])
        y = memory_cross_attention(h, mem_n, w_cq[l], w_ckv[l], w_co[l])
        x = x + rms_norm(y, g_x_post[l])
        h = rms_norm(x, g_ffn_pre[l])
        y = swiglu(h, w_gate[l], w_up[l], w_down[l])
        x = x + rms_norm(y, g_ffn_post[l])
    return x
```

```cpp
#include <hip/hip_runtime.h>
#include <hip/hip_bf16.h>
#include <cstdio>
#include <cstdint>
#include <cmath>
namespace pg8 {
#define PG8_LAS __attribute__((address_space(3)))
typedef unsigned short bf16_t;
typedef short bf16x8 __attribute__((ext_vector_type(8)));
typedef float f32x4 __attribute__((ext_vector_type(4)));
typedef unsigned u32x4 __attribute__((ext_vector_type(4)));
constexpr int BM = 256, BK = 64, HALF = 128, HTB = HALF * BK * 2  , STAGE_BYTES = 8 * HTB, NXCD = 8, WGM = 8;

__host__ __device__ __forceinline__ int lds_byte(int r, int c) { const int st = (r >> 4) * 2 + (c >> 5), rr = r & 15, cc = c & 31, ob = rr * 64 + cc * 2; return st * 1024 + (ob ^ (((ob >> 9) & 1) << 5)); }
__host__ __device__ __forceinline__ void stage_rc(int b, int& R, int& C) { const int st = b / 1024, sb = b % 1024, swz = sb ^ (((sb >> 9) & 1) << 5); R = (st >> 1) * 16 + swz / 64; C = (st & 1) * 32 + (swz % 64) / 2; }
__host__ __device__ __forceinline__ int perm32(int rho) { const int n = rho >> 4, i = rho & 15; return 8 * (i >> 2) + 4 * n + (i & 3); }

struct Unit { int pm, pn; };
struct Gemm { const bf16_t* A; const bf16_t* Bt; int M, N, K; };

struct StaticOrder {
    int nM, nN, nwg, G, c;
    __host__ __device__ void init(int M, int N, int G_, int c_) { nM = M / BM; nN = N / BM; nwg = nM * nN; G = G_; c = c_; }
    __host__ __device__ bool next(int i, Unit& u) const {
        const long L = (long)i * G + c; if (L >= nwg) return false;
        int wgid = (int)L; { const int q = nwg / NXCD, r = nwg % NXCD, xcd = wgid % NXCD, off = wgid / NXCD; wgid = (xcd < r ? xcd * (q + 1) : r * (q + 1) + (xcd - r) * q) + off; }
        const int nig = WGM * nN, gid = wgid / nig, fm = gid * WGM, gsz = (nM - fm) < WGM ? (nM - fm) : WGM;
        u.pm = fm + ((wgid % nig) % gsz); u.pn = (wgid % nig) / gsz; return true;
    }
    __device__ __forceinline__ void a_ready(const Unit&) const {}
    __device__ __forceinline__ void done(const Unit&) const {}
};

__device__ __forceinline__ unsigned cvt_pk_bf16(float lo, float hi) { unsigned r; asm volatile("v_cvt_pk_bf16_f32 %0, %1, %2" : "=v"(r) : "v"(lo), "v"(hi)); return r; }
typedef float f32x2 __attribute__((ext_vector_type(2)));
struct EpiStore {
    static constexpr bool PERM = true, AFTER_DRAIN = false;
    bf16_t* O; int ldc; const float* rope; int rope_tiles; int pn_mask;
    __device__ __forceinline__ void operator()(const f32x4 (&acc)[2][2][4][2], const Unit& u, int wr, int wc, int fr, int fq) const {
        const int row0 = u.pm * BM + wr * 64 + fr; const int col0 = (u.pn & pn_mask) * BM + wc * 32 + 8 * fq;
        const bool do_rope = u.pn < rope_tiles;
#pragma unroll
        for (int ai = 0; ai < 2; ++ai)
#pragma unroll
            for (int m = 0; m < 4; ++m) { const int row = row0 + ai * HALF + m * 16; bf16_t* rowp = O + (size_t)row * ldc + col0;
                f32x4 cs0 = {1.f, 0.f, 1.f, 0.f}, cs1 = {1.f, 0.f, 1.f, 0.f};
                if (do_rope) { const float* rp = rope + (size_t)row * 64 + (16 * (wc & 1) + 4 * fq) * 2; cs0 = *(const f32x4*)rp; cs1 = *(const f32x4*)(rp + 4); }
#pragma unroll
                for (int bj = 0; bj < 2; ++bj) { f32x4 v0 = acc[ai][bj][m][0], v1 = acc[ai][bj][m][1];
                    if (do_rope) {
                        f32x4 r0, r1;
                        r0[0] = v0[0] * cs0[0] - v0[1] * cs0[1]; r0[1] = v0[1] * cs0[0] + v0[0] * cs0[1];
                        r0[2] = v0[2] * cs0[2] - v0[3] * cs0[3]; r0[3] = v0[3] * cs0[2] + v0[2] * cs0[3];
                        r1[0] = v1[0] * cs1[0] - v1[1] * cs1[1]; r1[1] = v1[1] * cs1[0] + v1[0] * cs1[1];
                        r1[2] = v1[2] * cs1[2] - v1[3] * cs1[3]; r1[3] = v1[3] * cs1[2] + v1[2] * cs1[3];
                        v0 = r0; v1 = r1; }
                    u32x4 w; w.x = cvt_pk_bf16(v0[0], v0[1]); w.y = cvt_pk_bf16(v0[2], v0[3]); w.z = cvt_pk_bf16(v1[0], v1[1]); w.w = cvt_pk_bf16(v1[2], v1[3]);
                    *(u32x4*)(rowp + bj * HALF) = w; } }
    }
};
struct EpiSwiGLU {
    static constexpr bool PERM = true, AFTER_DRAIN = false;
    bf16_t* O; int ldc;
    __device__ __forceinline__ static float sw(float g, float up) { const float e = __builtin_amdgcn_exp2f(-1.4426950408889634f * g); return g * up * __builtin_amdgcn_rcpf(1.0f + e); }
    __device__ __forceinline__ void operator()(const f32x4 (&acc)[2][2][4][2], const Unit& u, int wr, int wc, int fr, int fq) const {
        const int row0 = u.pm * BM + wr * 64 + fr; const int col0 = u.pn * HALF + wc * 32 + 8 * fq;
#pragma unroll
        for (int ai = 0; ai < 2; ++ai)
#pragma unroll
            for (int m = 0; m < 4; ++m) { const int row = row0 + ai * HALF + m * 16; bf16_t* rowp = O + (size_t)row * ldc + col0;
                const f32x4 g0 = acc[ai][0][m][0], g1 = acc[ai][0][m][1], u0 = acc[ai][1][m][0], u1 = acc[ai][1][m][1];
                u32x4 w; w.x = cvt_pk_bf16(sw(g0[0], u0[0]), sw(g0[1], u0[1])); w.y = cvt_pk_bf16(sw(g0[2], u0[2]), sw(g0[3], u0[3]));
                w.z = cvt_pk_bf16(sw(g1[0], u1[0]), sw(g1[1], u1[1])); w.w = cvt_pk_bf16(sw(g1[2], u1[2]), sw(g1[3], u1[3]));
                *(u32x4*)rowp = w; }
    }
};
struct KvOrder {
    int G, c;
    __host__ __device__ bool next(int i, Unit& u) const { const int L = i * G + c; if (L >= 256) return false; const int l = L >> 6, r = L & 63; u.pm = 16 * l + (r >> 2); u.pn = 4 * l + (r & 3); return true; }
    __device__ __forceinline__ void a_ready(const Unit&) const {}
    __device__ __forceinline__ void done(const Unit&) const {}
};
template <class Epi, class Sched, bool ALIGN_EPI = false, bool SP2 = false>
__device__ __forceinline__ void gemm_phase(PG8_LAS unsigned char* lds, const Gemm g, const Sched& S, const Epi& E) {
    int tid_ = threadIdx.x; asm volatile("" : "+v"(tid_));
    const int tid = tid_, wid = __builtin_amdgcn_readfirstlane(tid >> 6), lane = tid & 63, wr = wid >> 2, wc = wid & 3, fr = lane & 15, fq = lane >> 4;
    const int K = g.K, nt = K / BK;
    unsigned voffA[2], voffB[2];
#pragma unroll
    for (int i = 0; i < 2; ++i) { int R, C; stage_rc(tid * 16 + i * 8192, R, C); const int Rb = Epi::PERM ? ((R & ~31) + perm32(R & 31)) : R;
        voffA[i] = (unsigned)(R * K + C) * 2u; voffB[i] = (unsigned)(Rb * K + C) * 2u; }
    const size_t kstep = (size_t)(BK * 2);
    const size_t hstep = (size_t)HALF * K * 2;
    const size_t tstep = 2 * hstep;
    const unsigned ldsw = (unsigned)wid * 1024u;
    const int aoff = lds_byte(wr * 64 + fr, fq * 8), boff = lds_byte(wc * 32 + fr, fq * 8);
#define PG8_SA(b, h) (((b) * 2 + (h)) * HTB)
#define PG8_SB(b, h) ((4 + (b) * 2 + (h)) * HTB)
#define PG8_STAGE(bufoff, gbase, voff) do { _Pragma("unroll") for (int _i = 0; _i < 2; ++_i) \
        __builtin_amdgcn_global_load_lds((const unsigned*)((const char*)(gbase) + (voff)[_i]), (PG8_LAS unsigned*)(lds + (bufoff) + ldsw + _i * 8192), 16, 0, 0); } while (0)
#define PG8_LDA(dst, b, h) do { _Pragma("unroll") for (int m = 0; m < 4; ++m) _Pragma("unroll") for (int k = 0; k < 2; ++k) dst[m][k] = *(const PG8_LAS bf16x8*)(lds + PG8_SA(b, h) + aoff + m * 2048 + k * 1024); } while (0)
#define PG8_LDB(dst, b, h) do { _Pragma("unroll") for (int n = 0; n < 2; ++n) _Pragma("unroll") for (int k = 0; k < 2; ++k) dst[n][k] = *(const PG8_LAS bf16x8*)(lds + PG8_SB(b, h) + boff + n * 2048 + k * 1024); } while (0)
#define PG8_MMA(ai, bj, At, Bt) do { __builtin_amdgcn_s_setprio(1); _Pragma("unroll") for (int m = 0; m < 4; ++m) _Pragma("unroll") for (int n = 0; n < 2; ++n) _Pragma("unroll") for (int k = 0; k < 2; ++k) \
        acc[ai][bj][m][n] = __builtin_amdgcn_mfma_f32_16x16x32_bf16(Bt[n][k], At[m][k], acc[ai][bj][m][n], 0, 0, 0); __builtin_amdgcn_s_setprio(0); } while (0)
#define PG8_WAIT_V(n) asm volatile("s_waitcnt vmcnt(" #n ")" ::: "memory")
#define PG8_WAIT_L(n) asm volatile("s_waitcnt lgkmcnt(" #n ")" ::: "memory")
#define PG8_BAR __builtin_amdgcn_s_barrier()
#define PG8_SCHED __builtin_amdgcn_sched_barrier(0)
    Unit cur, nxt; int ui = 0;
    if (!S.next(0, cur)) return;
    f32x4 acc[2][2][4][2];
#pragma unroll
    for (int a = 0; a < 2; ++a)
#pragma unroll
        for (int b = 0; b < 2; ++b)
#pragma unroll
            for (int m = 0; m < 4; ++m)
#pragma unroll
                for (int n = 0; n < 2; ++n) acc[a][b][m][n] = (f32x4){0.f, 0.f, 0.f, 0.f};
    bf16x8 At[4][2], B0[2][2], B1[2][2];
    const char* cA = (const char*)g.A + (size_t)cur.pm * tstep; const char* cB = (const char*)g.Bt + (size_t)cur.pn * tstep;
    S.a_ready(cur);
    if constexpr (SP2) {
        PG8_STAGE(PG8_SB(0, 0), cB, voffB); PG8_STAGE(PG8_SB(0, 1), cB + hstep, voffB); PG8_STAGE(PG8_SA(0, 0), cA, voffA); PG8_STAGE(PG8_SA(0, 1), cA + hstep, voffA);
        if (wr == 1) PG8_BAR;
        PG8_WAIT_V(2); PG8_BAR;
        PG8_STAGE(PG8_SB(1, 0), cB + kstep, voffB); PG8_STAGE(PG8_SA(1, 0), cA + kstep, voffA); PG8_STAGE(PG8_SB(1, 1), cB + hstep + kstep, voffB);
        PG8_WAIT_V(6); PG8_BAR;
    } else {
        PG8_STAGE(PG8_SB(0, 0), cB, voffB); PG8_STAGE(PG8_SA(0, 0), cA, voffA); PG8_STAGE(PG8_SB(0, 1), cB + hstep, voffB); PG8_STAGE(PG8_SA(0, 1), cA + hstep, voffA);
        if (wr == 1) PG8_BAR;
        PG8_WAIT_V(4); PG8_BAR;
        PG8_STAGE(PG8_SB(1, 0), cB + kstep, voffB); PG8_STAGE(PG8_SA(1, 0), cA + kstep, voffA); PG8_STAGE(PG8_SB(1, 1), cB + hstep + kstep, voffB);
        PG8_WAIT_V(6); PG8_BAR;
    }
    for (;;) {
        const bool has_next = S.next(ui + 1, nxt);
        const char* nA = has_next ? (const char*)g.A + (size_t)nxt.pm * tstep : cA; const char* nB = has_next ? (const char*)g.Bt + (size_t)nxt.pn * tstep : cB;
        for (int t = 0; t < nt; t += 2) {
            const bool last = (t == nt - 2);
            const char* a1 = cA + (size_t)(t + 1) * kstep;
            const char* a2 = last ? nA : cA + (size_t)(t + 2) * kstep; const char* b2 = last ? nB : cB + (size_t)(t + 2) * kstep;
            const char* a3 = a2 + kstep; const char* b3 = b2 + kstep;
            if (last && has_next) S.a_ready(nxt);
            if constexpr (SP2) {
            PG8_LDB(B0, 0, 0); PG8_LDB(B1, 0, 1); PG8_SCHED; PG8_LDA(At, 0, 0); PG8_STAGE(PG8_SA(1, 1), a1 + hstep, voffA);
            PG8_WAIT_V(8); PG8_WAIT_L(0); PG8_BAR; PG8_MMA(0, 0, At, B0); PG8_MMA(0, 1, At, B1); PG8_BAR; PG8_SCHED;
            PG8_LDA(At, 0, 1); PG8_STAGE(PG8_SB(0, 0), b2, voffB); PG8_STAGE(PG8_SB(0, 1), b2 + hstep, voffB); PG8_STAGE(PG8_SA(0, 0), a2, voffA);
            PG8_WAIT_V(8); PG8_WAIT_L(0); PG8_BAR; PG8_MMA(1, 0, At, B0); PG8_MMA(1, 1, At, B1); PG8_BAR; PG8_SCHED;
            PG8_LDB(B0, 1, 0); PG8_LDB(B1, 1, 1); PG8_SCHED; PG8_LDA(At, 1, 0); PG8_STAGE(PG8_SA(0, 1), a2 + hstep, voffA);
            PG8_WAIT_V(8); PG8_WAIT_L(0); PG8_BAR; PG8_MMA(0, 0, At, B0); PG8_MMA(0, 1, At, B1); PG8_BAR; PG8_SCHED;
            PG8_LDA(At, 1, 1); PG8_STAGE(PG8_SB(1, 0), b3, voffB); PG8_STAGE(PG8_SB(1, 1), b3 + hstep, voffB); PG8_STAGE(PG8_SA(1, 0), a3, voffA);
            PG8_WAIT_V(8); PG8_WAIT_L(0); PG8_BAR; PG8_MMA(1, 0, At, B0); PG8_MMA(1, 1, At, B1); PG8_BAR; PG8_SCHED;
            } else {
            PG8_LDB(B0, 0, 0); PG8_SCHED; PG8_LDA(At, 0, 0); PG8_STAGE(PG8_SA(1, 1), a1 + hstep, voffA);
            PG8_WAIT_L(8); PG8_BAR; PG8_WAIT_L(0); PG8_MMA(0, 0, At, B0); PG8_BAR; PG8_SCHED;
            PG8_LDB(B1, 0, 1); PG8_STAGE(PG8_SB(0, 0), b2, voffB);
            PG8_BAR; PG8_WAIT_L(0); PG8_MMA(0, 1, At, B1); PG8_BAR;
            PG8_LDA(At, 0, 1); PG8_STAGE(PG8_SA(0, 0), a2, voffA);
            PG8_BAR; PG8_WAIT_L(0); PG8_MMA(1, 0, At, B0); PG8_BAR; PG8_SCHED;
            PG8_STAGE(PG8_SB(0, 1), b2 + hstep, voffB);
            PG8_WAIT_V(6); PG8_BAR; PG8_MMA(1, 1, At, B1); PG8_BAR;
            PG8_LDB(B0, 1, 0); PG8_SCHED; PG8_LDA(At, 1, 0); PG8_STAGE(PG8_SA(0, 1), a2 + hstep, voffA);
            PG8_WAIT_L(8); PG8_BAR; PG8_WAIT_L(0); PG8_MMA(0, 0, At, B0); PG8_BAR; PG8_SCHED;
            PG8_LDB(B1, 1, 1); PG8_STAGE(PG8_SB(1, 0), b3, voffB);
            PG8_BAR; PG8_WAIT_L(0); PG8_MMA(0, 1, At, B1); PG8_BAR;
            PG8_LDA(At, 1, 1); PG8_STAGE(PG8_SA(1, 0), a3, voffA);
            PG8_BAR; PG8_WAIT_L(0); PG8_MMA(1, 0, At, B0); PG8_BAR; PG8_SCHED;
            PG8_STAGE(PG8_SB(1, 1), b3 + hstep, voffB);
            PG8_WAIT_V(6); PG8_BAR; PG8_MMA(1, 1, At, B1); PG8_BAR;
            }
        }
        if constexpr (ALIGN_EPI) { if (wr == 0) PG8_BAR; }
        if constexpr (!Epi::AFTER_DRAIN) { E(acc, cur, wr, wc, fr, fq); S.done(cur); }
        if (!has_next) break;
#pragma unroll
        for (int a = 0; a < 2; ++a)
#pragma unroll
            for (int b = 0; b < 2; ++b)
#pragma unroll
                for (int m = 0; m < 4; ++m)
#pragma unroll
                    for (int n = 0; n < 2; ++n) acc[a][b][m][n] = (f32x4){0.f, 0.f, 0.f, 0.f};
        cur = nxt; cA = nA; cB = nB; ++ui;
        if constexpr (ALIGN_EPI) { if (wr == 1) PG8_BAR; }
    }
    PG8_WAIT_V(0);
    if constexpr (!ALIGN_EPI) { if (wr == 0) PG8_BAR; }
    PG8_BAR;
    if constexpr (Epi::AFTER_DRAIN) { E.fused(acc, cur, wr, wc, fr, fq, lds, wid, lane); S.done(cur); }
#undef PG8_SA
#undef PG8_SB
#undef PG8_STAGE
#undef PG8_LDA
#undef PG8_LDB
#undef PG8_MMA
#undef PG8_WAIT_V
#undef PG8_WAIT_L
#undef PG8_BAR
#undef PG8_SCHED
}
}
namespace att {
#define ALAS __attribute__((address_space(3)))
typedef short bf16x8 __attribute__((ext_vector_type(8)));
typedef short s16x4 __attribute__((ext_vector_type(4)));
typedef float f32x16 __attribute__((ext_vector_type(16)));
typedef float f32x4 __attribute__((ext_vector_type(4)));
typedef unsigned u32x4 __attribute__((ext_vector_type(4)));
typedef unsigned short bf16_t;
constexpr int NW = 8, QBLK = 32, KVBLK = 64, QB = NW * QBLK;
constexpr int SHM_V = KVBLK * 128 * 2, SHM_K = KVBLK * 128 * 2;
constexpr int OFF_V = 0, OFF_K = 2 * SHM_V, OFF_WS = OFF_K + 2 * SHM_K, OFF_CUM = OFF_WS + NW * 64 * 4, OFF_MISC = OFF_CUM + 2048 * 4, ATT_LDS_BYTES = OFF_MISC + 256;
constexpr float LOG2E = 1.4426950408889634f;
#define KSWZ(row, colB) ((row) * 256 + ((colB) ^ (((row) & 7) << 4)))
#define SBAR() __builtin_amdgcn_sched_barrier(0)
__device__ __forceinline__ int v_st(int k, int c) { const int kk = (k & ~0xC) | ((k & 4) << 1) | ((k & 8) >> 1); return ((kk >> 3) * 4 + (c >> 5)) * 512 + ((kk & 7) * 32 + (c & 31)) * 2; }
__device__ __forceinline__ int v_rd_base(int lane) { return ((lane & 3) << 3) | (((lane >> 2) & 3) << 6) | (((lane >> 4) & 1) << 5) | (((lane >> 5) & 1) << 8); }
constexpr int v_rd_off(int d0, int ks, int half) { return d0 * 512 + ks * 4096 + half * 2048; }
__device__ __forceinline__ int crow(int r, int hi) { return (r & 3) + 8 * (r >> 2) + 4 * hi; }
__device__ __forceinline__ unsigned cvtpk(float lo, float hi) { unsigned r; asm volatile("v_cvt_pk_bf16_f32 %0, %1, %2" : "=v"(r) : "v"(lo), "v"(hi)); return r; }
__device__ __forceinline__ void mask_tile(f32x16& p0, f32x16& p1, int dq) {
    const float NEG = -__builtin_inff();
#pragma unroll
    for (int r = 0; r < 16; ++r) { const int c = (r & 3) + 8 * (r >> 2);
        if (dq - c < 0) p0[r] = NEG;
        if (dq - c - 32 < 0) p1[r] = NEG; }
}
__device__ __forceinline__ void pack_p(const f32x16& p0, const f32x16& p1, bf16x8& pa0, bf16x8& pa1, bf16x8& pa2, bf16x8& pa3) {
#define PK4(P, B_, OUT) do { unsigned a0 = cvtpk(P[B_+0], P[B_+1]), a1 = cvtpk(P[B_+2], P[B_+3]); unsigned b0 = cvtpk(P[B_+4], P[B_+5]), b1 = cvtpk(P[B_+6], P[B_+7]); \
        auto r0 = __builtin_amdgcn_permlane32_swap(a0, b0, false, false); auto r1 = __builtin_amdgcn_permlane32_swap(a1, b1, false, false); \
        u32x4 w = {r0[0], r1[0], r0[1], r1[1]}; OUT = __builtin_bit_cast(bf16x8, w); } while (0)
    PK4(p0, 0, pa0); PK4(p0, 8, pa1); PK4(p1, 0, pa2); PK4(p1, 8, pa3);
#undef PK4
}
template <int KB, int ND>
__device__ __forceinline__ void qkt(f32x16& p0, f32x16& p1, const ALAS char* K_lds, int r32, int hi, const bf16x8* qr, int koff) {
    p0 = f32x16{}; p1 = f32x16{};
    const ALAS char* kb[4];
#pragma unroll
    for (int dd = 0; dd < 4; ++dd) kb[dd] = K_lds + KB * SHM_K + KSWZ(r32, (dd * 16 + hi * 8) * 2) + koff;
#pragma unroll
    for (int d0 = 0; d0 < ND; ++d0) { const ALAS char* a = kb[d0 & 3] + (d0 >> 2) * 128;
        const bf16x8 b0 = *(const ALAS bf16x8*)(a);
        const bf16x8 b1 = *(const ALAS bf16x8*)(a + 32 * 256);
        p0 = __builtin_amdgcn_mfma_f32_32x32x16_bf16(b0, qr[d0], p0, 0, 0, 0);
        p1 = __builtin_amdgcn_mfma_f32_32x32x16_bf16(b1, qr[d0], p1, 0, 0, 0); }
}
template <int VB>
__device__ __forceinline__ void pv_tile(f32x16* o, int vb0, bf16x8 pa0, bf16x8 pa1, bf16x8 pa2, bf16x8 pa3) {
#define TRRD(dst, off) asm volatile("ds_read_b64_tr_b16 %0, %1 offset:%2" : "=&v"(dst) : "v"(vb0), "i"(off) : "memory")
#define PV_D0(d0) do { s16x4 l0, l1, l2, l3, h0, h1, h2, h3; constexpr int b_ = VB * SHM_V + v_rd_off(d0, 0, 0); \
        TRRD(l0, b_); TRRD(h0, b_ + 2048); TRRD(l1, b_ + 4096); TRRD(h1, b_ + 6144); TRRD(l2, b_ + 8192); TRRD(h2, b_ + 10240); TRRD(l3, b_ + 12288); TRRD(h3, b_ + 14336); \
        asm volatile("s_waitcnt lgkmcnt(0)" ::: "memory"); SBAR(); \
        o[d0] = __builtin_amdgcn_mfma_f32_32x32x16_bf16(pa0, (bf16x8){l0[0], l0[1], l0[2], l0[3], h0[0], h0[1], h0[2], h0[3]}, o[d0], 0, 0, 0); \
        o[d0] = __builtin_amdgcn_mfma_f32_32x32x16_bf16(pa1, (bf16x8){l1[0], l1[1], l1[2], l1[3], h1[0], h1[1], h1[2], h1[3]}, o[d0], 0, 0, 0); \
        o[d0] = __builtin_amdgcn_mfma_f32_32x32x16_bf16(pa2, (bf16x8){l2[0], l2[1], l2[2], l2[3], h2[0], h2[1], h2[2], h2[3]}, o[d0], 0, 0, 0); \
        o[d0] = __builtin_amdgcn_mfma_f32_32x32x16_bf16(pa3, (bf16x8){l3[0], l3[1], l3[2], l3[3], h3[0], h3[1], h3[2], h3[3]}, o[d0], 0, 0, 0); } while (0)
    PV_D0(0); PV_D0(1); PV_D0(2); PV_D0(3);
#undef PV_D0
#undef TRRD
}
__device__ __forceinline__ float swap_max(float v) { auto rr = __builtin_amdgcn_permlane32_swap(__float_as_uint(v), __float_as_uint(v), false, false); return fmaxf(__uint_as_float(rr[0]), __uint_as_float(rr[1])); }
__device__ __forceinline__ float swap_sum(float v) { auto rr = __builtin_amdgcn_permlane32_swap(__float_as_uint(v), __float_as_uint(v), false, false); return __uint_as_float(rr[0]) + __uint_as_float(rr[1]); }

template <int MODE>
__device__ __forceinline__ void attn_unit(const bf16_t* Q, int qp, const bf16_t* K, const bf16_t* V, int kvp, bf16_t* O, int op, int pos0, int NT, int koff, const float* logf, ALAS char* lds) {
    constexpr int ND = (MODE == 0) ? 4 : 8;
    constexpr bool CAUSAL = (MODE != 3), SB = (MODE == 1);
    constexpr float SCALE = (MODE == 0) ? 0.125f : 0.08838834764831845f;
    constexpr float C2 = SCALE * LOG2E;
    constexpr float THR2 = 8.f * LOG2E;
    int tid_ = threadIdx.x; asm volatile("" : "+v"(tid_));
    const int tid = tid_, wid = __builtin_amdgcn_readfirstlane(tid >> 6), lane = tid & 63, r32 = lane & 31, hi = lane >> 5;
    const ALAS char* V_lds = lds + OFF_V; const ALAS char* K_lds = lds + OFF_K;
    ALAS float* wsf = (ALAS float*)(lds + OFF_WS) + wid * 64; ALAS float* li_l = wsf; ALAS float* al_l = wsf + 32;
    ALAS float* cum2 = (ALAS float*)(lds + OFF_CUM);
    const int sr = tid >> 4, sc = (tid & 15) * 8, vst0 = v_st(sr, sc), vst1 = v_st(32 + sr, sc), kws = KSWZ(sr, sc * 2);
    const int vb0 = (int)(uintptr_t)(V_lds) + v_rd_base(lane);
    float cq2 = 0.f;
    if constexpr (MODE == 2) {
        const f32x4 v = *(const f32x4*)(logf + 4 * tid);
        const float a0 = v[0], a1 = a0 + v[1], a2 = a1 + v[2], a3 = a2 + v[3];
        float s = a3;
#pragma unroll
        for (int off = 1; off < 64; off <<= 1) { const float t = __shfl_up(s, off); if (lane >= off) s += t; }
        ALAS float* wt = (ALAS float*)(lds + OFF_MISC) + 16;
        if (lane == 63) wt[wid] = s;
        __syncthreads();
        float base = 0.f;
#pragma unroll
        for (int w = 0; w < NW; ++w) { const float t = wt[w]; if (w < wid) base += t; }
        const float ex = s - a3 + base;
        f32x4 c; c[0] = (ex + a0) * LOG2E; c[1] = (ex + a1) * LOG2E; c[2] = (ex + a2) * LOG2E; c[3] = (ex + a3) * LOG2E;
        *(ALAS f32x4*)(cum2 + 4 * tid) = c;
        __syncthreads();
        cq2 = cum2[pos0 + wid * QBLK + r32];
    }
    bf16x8 qr[ND];
#pragma unroll
    for (int d0 = 0; d0 < ND; ++d0) qr[d0] = *(const bf16x8*)(Q + (size_t)(wid * QBLK + r32) * qp + d0 * 16 + hi * 8);
    const int qlo = pos0 + wid * QBLK;
    const int qm = pos0 + wid * QBLK + r32 - 4 * hi - (SB ? 1 : 0);
    float m_reg = -1e30f, l_reg = 0.f, carry = 0.f; f32x16 o[4] = {};
    bf16x8 st_k0, st_k1, st_v0, st_v1;
#define TILE_OF(it) (SB ? (NT - 1 - (it)) : (it))
#define GROW(p, k0, rr) ((p) + (size_t)((k0) + (rr)) * kvp + sc)
#define SLOAD(k0) do { st_v0 = *(const bf16x8*)GROW(V, k0, sr); st_v1 = *(const bf16x8*)GROW(V, k0, 32 + sr); st_k0 = *(const bf16x8*)GROW(K, k0, sr); st_k1 = *(const bf16x8*)GROW(K, k0, 32 + sr); } while (0)
#define SWRITE(bf) do { *(ALAS bf16x8*)(lds + OFF_K + (bf) * SHM_K + kws) = st_k0; *(ALAS bf16x8*)(lds + OFF_K + (bf) * SHM_K + kws + 32 * 256) = st_k1; \
                        *(ALAS bf16x8*)(lds + OFF_V + (bf) * SHM_V + vst0) = st_v0; *(ALAS bf16x8*)(lds + OFF_V + (bf) * SHM_V + vst1) = st_v1; } while (0)
    SLOAD(TILE_OF(0) * KVBLK); SWRITE(0);
    __syncthreads();
    f32x16 p0, p1; bf16x8 pa0, pa1, pa2, pa3;
#define STEP(it, BUF) do { \
        const int kb_ = TILE_OF(it) * KVBLK; \
        if ((it) + 1 < NT) SLOAD(TILE_OF((it) + 1) * KVBLK); \
        SBAR(); qkt<BUF, ND>(p0, p1, K_lds, r32, hi, qr, koff); SBAR(); \
        if constexpr (SB) { \
            _Pragma("unroll") for (int r = 0; r < 16; ++r) { p0[r] *= C2; p1[r] *= C2; } \
            if (kb_ + KVBLK - 1 > qlo - 1) mask_tile(p0, p1, qm - kb_); \
            float G0[4], G1[4]; \
            _Pragma("unroll") for (int g = 0; g < 4; ++g) { float s0 = 0.f, s1 = 0.f; \
                _Pragma("unroll") for (int k = 3; k >= 0; --k) { const int r = 4 * g + k; \
                    { const float z = p0[r]; const float sp = fmaxf(z, 0.f) + __builtin_amdgcn_logf(1.0f + __builtin_amdgcn_exp2f(-fabsf(z))); p0[r] = (z - sp) + s0; s0 -= sp; } \
                    { const float z = p1[r]; const float sp = fmaxf(z, 0.f) + __builtin_amdgcn_logf(1.0f + __builtin_amdgcn_exp2f(-fabsf(z))); p1[r] = (z - sp) + s1; s1 -= sp; } } \
                G0[g] = s0; G1[g] = s1; } \
            float run = carry; float offv[8]; \
            _Pragma("unroll") for (int b = 7; b >= 0; --b) { const float gsum = (b >= 4) ? G1[b - 4] : G0[b]; \
                auto rr = __builtin_amdgcn_permlane32_swap(__float_as_uint(gsum), __float_as_uint(gsum), false, false); \
                const float glo = __uint_as_float(rr[0]), ghi = __uint_as_float(rr[1]); \
                offv[b] = run + (hi == 0 ? ghi : 0.f); run += glo + ghi; } \
            carry = run; \
            _Pragma("unroll") for (int r = 0; r < 16; ++r) { p0[r] = __builtin_amdgcn_exp2f(p0[r] + offv[r >> 2]); p1[r] = __builtin_amdgcn_exp2f(p1[r] + offv[4 + (r >> 2)]); } \
        } else { \
            if constexpr (MODE == 2) { \
                _Pragma("unroll") for (int g = 0; g < 4; ++g) { const f32x4 c0 = *(const ALAS f32x4*)(cum2 + kb_ + 8 * g + 4 * hi); const f32x4 c1 = *(const ALAS f32x4*)(cum2 + kb_ + 32 + 8 * g + 4 * hi); \
                    _Pragma("unroll") for (int k = 0; k < 4; ++k) { p0[4 * g + k] = fmaf(p0[4 * g + k], C2, cq2 - c0[k]); p1[4 * g + k] = fmaf(p1[4 * g + k], C2, cq2 - c1[k]); } } \
            } else { _Pragma("unroll") for (int r = 0; r < 16; ++r) { p0[r] *= C2; p1[r] *= C2; } } \
            if constexpr (CAUSAL) { if (kb_ + KVBLK - 1 > qlo) mask_tile(p0, p1, qm - kb_); } \
            float pmax = p0[0]; \
            _Pragma("unroll") for (int r = 1; r < 16; ++r) pmax = fmaxf(pmax, p0[r]); \
            _Pragma("unroll") for (int r = 0; r < 16; ++r) pmax = fmaxf(pmax, p1[r]); \
            pmax = swap_max(pmax); \
            float mn, alpha; \
            if (__all(pmax - m_reg <= THR2)) { mn = m_reg; alpha = 1.f; } \
            else { mn = fmaxf(m_reg, pmax); alpha = __builtin_amdgcn_exp2f(m_reg - mn); m_reg = mn; } \
            float ps = 0.f; \
            _Pragma("unroll") for (int r = 0; r < 16; ++r) { p0[r] = __builtin_amdgcn_exp2f(p0[r] - mn); p1[r] = __builtin_amdgcn_exp2f(p1[r] - mn); ps += p0[r] + p1[r]; } \
            ps = swap_sum(ps); l_reg = l_reg * alpha + ps; \
            if (__any(alpha < 1.f)) { if (hi == 0) al_l[r32] = alpha; asm volatile("s_waitcnt lgkmcnt(0)" ::: "memory"); \
                _Pragma("unroll") for (int d_ = 0; d_ < 4; ++d_) _Pragma("unroll") for (int r = 0; r < 16; ++r) o[d_][r] *= al_l[crow(r, hi)]; } \
        } \
        pack_p(p0, p1, pa0, pa1, pa2, pa3); SBAR(); \
        pv_tile<BUF>(o, vb0, pa0, pa1, pa2, pa3); SBAR(); \
        if ((it) + 1 < NT) SWRITE((BUF) ^ 1); \
        __syncthreads(); } while (0)
    for (int it = 0; it < NT; it += 2) { STEP(it, 0); STEP(it + 1, 1); }
#undef STEP
#undef SWRITE
#undef SLOAD
#undef GROW
#undef TILE_OF
    float rli[16];
    if constexpr (SB) {
#pragma unroll
        for (int r = 0; r < 16; ++r) rli[r] = 1.f;
    } else {
        if (hi == 0) li_l[r32] = l_reg; asm volatile("s_waitcnt lgkmcnt(0)" ::: "memory");
#pragma unroll
        for (int r = 0; r < 16; ++r) rli[r] = __builtin_amdgcn_rcpf(li_l[crow(r, hi)]);
    }
    bf16_t* Ow = O + (size_t)(wid * QBLK) * op;
#pragma unroll
    for (int r = 0; r < 16; ++r) { const int orow = crow(r, hi);
#pragma unroll
        for (int d0 = 0; d0 < 4; ++d0) { const float v = o[d0][r] * rli[r]; const float vn = __shfl_xor(v, 1);
            if ((r32 & 1) == 0) *(unsigned*)(Ow + (size_t)orow * op + d0 * 32 + r32) = cvtpk(v, vn); } }
    __syncthreads();
}
#undef SBAR
#undef KSWZ
}
#define GAS __attribute__((address_space(1)))
#define LAS __attribute__((address_space(3)))
typedef unsigned short bf16;
typedef unsigned v4u __attribute__((ext_vector_type(4)));
typedef float f32x4 __attribute__((ext_vector_type(4)));
typedef short bf16x8 __attribute__((ext_vector_type(8)));
typedef GAS unsigned gu32;
typedef GAS unsigned long long gu64;
#define RLX_AGENT __ATOMIC_RELAXED, __HIP_MEMORY_SCOPE_AGENT
#define LDS_WAIT() asm volatile("s_waitcnt lgkmcnt(0)" ::: "memory")
#define VM_WAIT() asm volatile("s_waitcnt vmcnt(0)" ::: "memory")
__device__ __forceinline__ unsigned long long rt() { return __builtin_amdgcn_s_memrealtime(); }
__device__ __forceinline__ unsigned f2bf(float f) { unsigned u = __builtin_bit_cast(unsigned, f); return (u + 0x7fffu + ((u >> 16) & 1u)) >> 16; }
__device__ __forceinline__ unsigned pk2(float lo, float hi) { return f2bf(lo) | (f2bf(hi) << 16); }

#define XB_TMO      128
#define XB_XCNT(j)  (256  + 64 * (j))
#define XB_XSUB(j)  (1280 + 64 * (j))
#define XB_XGEN(j)  (2304 + 64 * (j))
#define XB_TOP      3328
#define XB_TOPGEN   3392
#define XCD_BAR_WORDS 3456
#define XB_SPIN_CAP (1u << 18)

__device__ __forceinline__ unsigned xb_ld(unsigned* p)              { return __hip_atomic_load(p, __ATOMIC_RELAXED, __HIP_MEMORY_SCOPE_AGENT); }
__device__ __forceinline__ unsigned xb_add(unsigned* p, unsigned v) { return __hip_atomic_fetch_add(p, v, __ATOMIC_RELAXED, __HIP_MEMORY_SCOPE_AGENT); }
__device__ __forceinline__ unsigned xb_xcc_id() { return (unsigned)__builtin_amdgcn_s_getreg((3 << 11) | 20) & 0xFu; }
#define XB_SPIN(cond, bar) do { unsigned _sp = 0; while (cond) { __builtin_amdgcn_s_sleep(1); \
    if ((++_sp & 255u) == 0u) { if (xb_ld(&(bar)[XB_TMO])) break; if (_sp > XB_SPIN_CAP) { atomicAdd(&(bar)[XB_TMO], 1u); break; } } } } while (0)

struct XcdBarrier {
    unsigned* bar; unsigned x;
    volatile LAS unsigned* st;
};

__device__ __forceinline__ XcdBarrier xcd_barrier_post(unsigned* bar, volatile LAS unsigned* st) {
    XcdBarrier b; b.bar = bar; b.x = xb_xcc_id(); b.st = st;
    if (threadIdx.x == 0) (void)xb_add(&bar[XB_XCNT(b.x)], 1u);
    return b;
}
__device__ __forceinline__ void xcd_barrier_complete(unsigned* bar, unsigned x, unsigned& nloc, unsigned& nx) {
    const unsigned G = gridDim.x * gridDim.y * gridDim.z;
    unsigned sum, cnt, mine, sp = 0u;
    for (;;) {
        sum = 0u; cnt = 0u; mine = 0u;
#pragma unroll
        for (unsigned j = 0; j < 16; ++j) { const unsigned c = xb_ld(&bar[XB_XCNT(j)]); sum += c; cnt += (c > 0u) ? 1u : 0u; mine = (j == x) ? c : mine; }
        if (sum == G) break;
        __builtin_amdgcn_s_sleep(1);
        if ((++sp & 255u) == 0u) { if (xb_ld(&bar[XB_TMO])) break; if (sp > XB_SPIN_CAP) { atomicAdd(&bar[XB_TMO], 1u); break; } }
    }
    nloc = mine > 0u ? mine : 1u; nx = cnt > 0u ? cnt : 1u;
}

__device__ __forceinline__ void xcd_barrier(const XcdBarrier& b) {
    asm volatile("s_waitcnt vmcnt(0)" ::: "memory");
    __syncthreads();
    if (threadIdx.x == 0) {
        unsigned* bar = b.bar;
        __builtin_amdgcn_s_waitcnt(0);
        unsigned nloc = b.st[0], nx = b.st[1];
        if (nloc == 0u) { xcd_barrier_complete(bar, b.x, nloc, nx); b.st[0] = nloc; b.st[1] = nx; }
        const unsigned old = xb_add(&bar[XB_XSUB(b.x)], 1u);
        const unsigned gen = old / nloc;
        if (old + 1u == (gen + 1u) * nloc) {
            __builtin_amdgcn_fence(__ATOMIC_RELEASE, "agent");
            asm volatile("s_waitcnt vmcnt(0)" ::: "memory");
            const unsigned og = xb_add(&bar[XB_TOP], 1u);
            const unsigned tg = og / nx;
            if (og + 1u == (tg + 1u) * nx) xb_add(&bar[XB_TOPGEN], 1u);
            else XB_SPIN(xb_ld(&bar[XB_TOPGEN]) == tg, bar);
            __builtin_amdgcn_fence(__ATOMIC_ACQUIRE, "agent");
            xb_add(&bar[XB_XGEN(b.x)], 1u);
            asm volatile("s_waitcnt vmcnt(0)" ::: "memory");
        } else {
            XB_SPIN(xb_ld(&bar[XB_XGEN(b.x)]) == gen, bar);
            __builtin_amdgcn_fence(__ATOMIC_ACQUIRE, "agent");
            asm volatile("s_waitcnt vmcnt(0)" ::: "memory");
        }
    }
    __syncthreads();
}
constexpr int NWAVES = 8;
constexpr int BATCH = 16, SEQ = 2048, DM = 2048, DEPTH = 4, MEMLEN = 256;
constexpr int M = BATCH * SEQ;
constexpr int MM = BATCH * MEMLEN;
constexpr int NPROJ = 6144, INCOLS = 6150, DFF = 5632, CROSSW = 512;
constexpr int QA_C = 0, KA_C = 512, VA_C = 1024, QB_C = 1536, KB_C = 2304, VB_C = 3072, QC_C = 3840, KC_C = 4608, VC_C = 5376;
constexpr float EPS = 1e-6f;
constexpr int N_PHASES = 1 + 12 * DEPTH;
#ifndef PH_MASK
#define PH_MASK 0x1fff
#endif
#define EN(k) (((PH_MASK) >> (k)) & 1)
#ifndef EN_A0
#define EN_A0 1
#endif
#ifndef EN_A1
#define EN_A1 1
#endif
#ifndef EN_A2
#define EN_A2 1
#endif
#ifndef EN_G0
#define EN_G0 1
#endif
#ifndef ROPE_TILES
#define ROPE_TILES 4
#endif
#ifndef MK_ONE_LAUNCH
#define MK_ONE_LAUNCH 0
#endif

constexpr size_t MiB = 1u << 20;
constexpr size_t WS_CTL = 0, CTL_ZERO_BYTES = 1 * MiB;
constexpr size_t WS_ROPE = 1 * MiB;
constexpr size_t WS_LOGF = 9 * MiB;
constexpr size_t WS_KV = 10 * MiB;
constexpr size_t WS_W = 42 * MiB, W_LAYER = 102 * MiB;
constexpr size_t WO_IN = 0, WO_OUT = 24 * MiB, WO_CQ = 32 * MiB, WO_CO = 34 * MiB, WO_GU = 36 * MiB, WO_DN = 80 * MiB;
constexpr size_t WS_HB = 450 * MiB;
constexpr size_t WS_YB = 578 * MiB;
constexpr size_t WS_MEMN = WS_YB, WS_WCKV = WS_YB + 64 * MiB, WS_OA = WS_YB;
constexpr size_t WS_BIG = 706 * MiB;
constexpr size_t WS_QX = WS_BIG, WS_O2 = WS_BIG + 32 * MiB;
constexpr size_t WS_END = 1090 * MiB;
constexpr int CW_TMO = 0, CW_BAR = 4096, CW_Q = 16384;

constexpr int RING_BYTES = 131072, LDSCTL_OFF = RING_BYTES, MISC_OFF = LDSCTL_OFF + 320, LDS_BYTES = 147456;
static_assert(att::ATT_LDS_BYTES <= RING_BYTES, "attention scratch inside the ring region");

__device__ const double kInvFreq[32] = { 1.0, 0.7498942093324559, 0.5623413251903491, 0.4216965034285822, 0.31622776601683794, 0.23713737056616552, 0.1778279410038923, 0.1333521432163324,
    0.1, 0.07498942093324558, 0.05623413251903491, 0.042169650342858224, 0.03162277660168379, 0.023713737056616554, 0.01778279410038923, 0.01333521432163324,
    0.01, 0.007498942093324558, 0.005623413251903491, 0.004216965034285823, 0.0031622776601683794, 0.0023713737056616554, 0.0017782794100389228, 0.001333521432163324,
    0.001, 0.0007498942093324559, 0.0005623413251903491, 0.00042169650342858224, 0.00031622776601683794, 0.00023713737056616554, 0.00017782794100389227, 0.0001333521432163324 };

struct Args {
    const float* x; const float* mem; const int* pos;
    const float *g_mix_pre, *g_mix_post, *w_in, *b_f, *lam_q1, *lam_k1, *lam_q2, *lam_k2, *g_diff_sub, *g_sb_out, *g_fox_out, *w_out;
    const float *g_x_pre, *g_x_post, *g_mem, *w_cq, *w_ckv, *w_co, *g_ffn_pre, *g_ffn_post, *w_gate, *w_up, *w_down;
    float* out; unsigned char* ws; int ph_lo, ph_hi, li, pad;
};

typedef unsigned u32x2 __attribute__((ext_vector_type(2)));
struct Frame { LAS unsigned char* lds; int tid, lane, wave, vcu, G; };
#define PHASE_FENCE(F) do { int t_ = threadIdx.x; asm volatile("" : "+v"(t_)); (F).tid = t_; (F).lane = t_ & 63; } while (0)

__device__ __forceinline__ float wave_sum(float v) {
#pragma unroll
    for (int o = 1; o < 64; o <<= 1) v += __shfl_xor(v, o);
    return v;
}
__device__ __forceinline__ unsigned pkbf(float lo, float hi) { return pg8::cvt_pk_bf16(lo, hi); }
__device__ __forceinline__ float bflo(unsigned w) { return __uint_as_float(w << 16); }
__device__ __forceinline__ float bfhi(unsigned w) { return __uint_as_float(w & 0xffff0000u); }

__device__ __forceinline__ void transpose_item(const float* W, int ld, int K, int k0, int scol, bf16* WT, int n0, LAS float* scr, int lane) {
#pragma unroll 8
    for (int i = 0; i < 32; ++i) { const int kk = 2 * i + (lane >> 5); scr[kk * 33 + (lane & 31)] = W[(size_t)(k0 + kk) * ld + scol]; }
    LDS_WAIT(); asm volatile("" ::: "memory");
    const int c = lane & 7;
#pragma unroll
    for (int j = 0; j < 4; ++j) { const int n = (lane >> 3) + 8 * j; const LAS float* s = scr + (8 * c) * 33 + n;
        v4u o; o.x = pkbf(s[0 * 33], s[1 * 33]); o.y = pkbf(s[2 * 33], s[3 * 33]); o.z = pkbf(s[4 * 33], s[5 * 33]); o.w = pkbf(s[6 * 33], s[7 * 33]);
        *(GAS v4u*)(WT + (size_t)(n0 + n) * K + k0 + 8 * c) = o; }
    LDS_WAIT(); asm volatile("" ::: "memory");
}
__device__ __forceinline__ void p0_weights(Frame& F, const Args& a, unsigned char* ws) {
    LAS float* scr = (LAS float*)(F.lds + F.wave * 16384);
    const int gw = F.vcu * NWAVES + F.wave, NGW = F.G * NWAVES, j = F.lane & 31;
    constexpr int I_IN = 32 * 192, I_OUT = 32 * 64, I_CQ = 32 * 16, I_CKV = 32 * 32, I_CO = 8 * 64, I_GU = 32 * 352, I_DN = 88 * 64;
    constexpr int I_LAYER = I_IN + I_OUT + I_CQ + I_CKV + I_CO + I_GU + I_DN;
    for (int it = gw; it < DEPTH * I_LAYER; it += NGW) {
        const int l = it / I_LAYER; int r = it - l * I_LAYER;
        unsigned char* wl = ws + WS_W + (size_t)l * W_LAYER;
        if (r < I_IN) { const int kb = r / 192, nb = r % 192, n = 32 * nb + j; int sc = n; if (n < 1024) { const int p = n & 63; sc = (n & ~63) + (p >> 1) + 32 * (p & 1); }
            transpose_item(a.w_in + (size_t)l * DM * INCOLS, INCOLS, DM, 64 * kb, sc, (bf16*)(wl + WO_IN), 32 * nb, scr, F.lane); continue; } r -= I_IN;
        if (r < I_OUT) { const int kb = r / 64, nb = r % 64; transpose_item(a.w_out + (size_t)l * DM * DM, DM, DM, 64 * kb, 32 * nb + j, (bf16*)(wl + WO_OUT), 32 * nb, scr, F.lane); continue; } r -= I_OUT;
        if (r < I_CQ) { const int kb = r / 16, nb = r % 16; transpose_item(a.w_cq + (size_t)l * DM * CROSSW, CROSSW, DM, 64 * kb, 32 * nb + j, (bf16*)(wl + WO_CQ), 32 * nb, scr, F.lane); continue; } r -= I_CQ;
        if (r < I_CKV) { const int kb = r / 32, nb = r % 32; transpose_item(a.w_ckv + (size_t)l * DM * 1024, 1024, DM, 64 * kb, 32 * nb + j, (bf16*)(ws + WS_WCKV) + (size_t)l * 1024 * DM, 32 * nb, scr, F.lane); continue; } r -= I_CKV;
        if (r < I_CO) { const int kb = r / 64, nb = r % 64; transpose_item(a.w_co + (size_t)l * CROSSW * DM, DM, CROSSW, 64 * kb, 32 * nb + j, (bf16*)(wl + WO_CO), 32 * nb, scr, F.lane); continue; } r -= I_CO;
        if (r < I_GU) { const int kb = r / 352, nb = r % 352, n = 32 * nb + j, pn = n >> 8, rr = n & 255; const float* src = (rr < 128 ? a.w_gate : a.w_up) + (size_t)l * DM * DFF;
            transpose_item(src, DFF, DM, 64 * kb, 128 * pn + (rr & 127), (bf16*)(wl + WO_GU), 32 * nb, scr, F.lane); continue; } r -= I_GU;
        { const int kb = r / 64, nb = r % 64; transpose_item(a.w_down + (size_t)l * DFF * DM, DM, DFF, 64 * kb, 32 * nb + j, (bf16*)(wl + WO_DN), 32 * nb, scr, F.lane); }
    }
}
__device__ __forceinline__ void p0_rope(Frame& F, const Args& a, unsigned char* ws) {
    float* tab = (float*)(ws + WS_ROPE);
    const int gt = (F.vcu * NWAVES + F.wave) * 64 + F.lane, NT = F.G * NWAVES * 64;
    for (int e = gt; e < M * 32; e += NT) { const int m = e >> 5, i = e & 31;
        const double ang = (double)a.pos[m] * kInvFreq[i]; const double rev = ang * 0.15915494309189535; const double fr = rev - __builtin_floor(rev);
        const float frf = (float)fr;
        tab[(size_t)e * 2] = __builtin_amdgcn_cosf(frf); tab[(size_t)e * 2 + 1] = __builtin_amdgcn_sinf(frf); }
}
__device__ __forceinline__ void p0_memn(Frame& F, const Args& a, unsigned char* ws) {
    const int gw = F.vcu * NWAVES + F.wave, NGW = F.G * NWAVES;
    for (int t = gw; t < DEPTH * MM; t += NGW) { const int l = t / MM, r = t - l * MM;
        const GAS f32x4* xr = (const GAS f32x4*)(a.mem + (size_t)r * DM) + F.lane; const GAS f32x4* gr = (const GAS f32x4*)(a.g_mem + (size_t)l * DM) + F.lane;
        f32x4 v[8]; float s = 0.f;
#pragma unroll
        for (int j = 0; j < 8; ++j) { v[j] = xr[64 * j]; s += (v[j].x * v[j].x + v[j].y * v[j].y) + (v[j].z * v[j].z + v[j].w * v[j].w); }
        const float rstd = 1.f / sqrtf(wave_sum(s) * (1.f / DM) + EPS);
        GAS unsigned long long* o8 = (GAS unsigned long long*)((bf16*)(ws + WS_MEMN) + (size_t)t * DM) + F.lane;
#pragma unroll
        for (int j = 0; j < 8; ++j) { const f32x4 g = gr[64 * j]; o8[64 * j] = (unsigned long long)pkbf(v[j].x * rstd * g.x, v[j].y * rstd * g.y) | ((unsigned long long)pkbf(v[j].z * rstd * g.z, v[j].w * rstd * g.w) << 32); }
    }
}
template <bool FC>
__device__ __forceinline__ void row_phase(Frame& F, const bf16* y, const float* gpost, const float* xsrc, float* xdst, const float* gpre, bf16* hdst,
                                          const float* wfc_src  , const float* bfv, float* logf) {
    const int gw = F.vcu * NWAVES + F.wave, NGW = F.G * NWAVES;
    LAS float* wfc = (LAS float*)F.lds;
    if constexpr (FC) {
        for (int e = F.tid; e < 6 * DM; e += NWAVES * 64) { const int k = e / 6, jj = e - 6 * k; wfc[jj * DM + k] = wfc_src[(size_t)k * INCOLS + NPROJ + jj]; }
        __syncthreads();
    }
    f32x4 gp[8], gq[8];
#pragma unroll
    for (int j = 0; j < 8; ++j) { gp[j] = y ? ((const GAS f32x4*)gpost)[F.lane + 64 * j] : (f32x4){0.f, 0.f, 0.f, 0.f}; gq[j] = gpre ? ((const GAS f32x4*)gpre)[F.lane + 64 * j] : (f32x4){0.f, 0.f, 0.f, 0.f}; }
    for (int m = gw; m < M; m += NGW) {
        f32x4 v[8];
        const GAS f32x4* xr = (const GAS f32x4*)(xsrc + (size_t)m * DM) + F.lane;
#pragma unroll
        for (int j = 0; j < 8; ++j) v[j] = xr[64 * j];
        if (y) {
            const GAS u32x2* yr = (const GAS u32x2*)(y + (size_t)m * DM) + F.lane; f32x4 yv[8]; float s = 0.f;
#pragma unroll
            for (int j = 0; j < 8; ++j) { const u32x2 w = yr[64 * j]; yv[j] = (f32x4){bflo(w.x), bfhi(w.x), bflo(w.y), bfhi(w.y)}; s += (yv[j].x * yv[j].x + yv[j].y * yv[j].y) + (yv[j].z * yv[j].z + yv[j].w * yv[j].w); }
            const float rstd = 1.f / sqrtf(wave_sum(s) * (1.f / DM) + EPS);
            GAS f32x4* xo = (GAS f32x4*)(xdst + (size_t)m * DM) + F.lane;
#pragma unroll
            for (int j = 0; j < 8; ++j) { v[j] = v[j] + yv[j] * rstd * gp[j]; xo[64 * j] = v[j]; }
        }
        if (gpre) {
            float s = 0.f;
#pragma unroll
            for (int j = 0; j < 8; ++j) s += (v[j].x * v[j].x + v[j].y * v[j].y) + (v[j].z * v[j].z + v[j].w * v[j].w);
            const float rstd = 1.f / sqrtf(wave_sum(s) * (1.f / DM) + EPS);
            GAS unsigned long long* o8 = (GAS unsigned long long*)(hdst + (size_t)m * DM) + F.lane;
#pragma unroll
            for (int j = 0; j < 8; ++j) { v[j] = v[j] * rstd * gq[j]; o8[64 * j] = (unsigned long long)pkbf(v[j].x, v[j].y) | ((unsigned long long)pkbf(v[j].z, v[j].w) << 32); }
            if constexpr (FC) {
                float fc[6];
#pragma unroll
                for (int jj = 0; jj < 6; ++jj) { float acc = 0.f;
#pragma unroll
                    for (int j = 0; j < 8; ++j) { const f32x4 w = *(const LAS f32x4*)(wfc + jj * DM + 4 * F.lane + 256 * j); acc += (v[j].x * w.x + v[j].y * w.y) + (v[j].z * w.z + v[j].w * w.w); }
                    fc[jj] = wave_sum(acc); }
                if (F.lane < 6) { float t = fc[0];
#pragma unroll
                    for (int jj = 1; jj < 6; ++jj) t = (F.lane == jj) ? fc[jj] : t;
                    const float z = t + bfv[F.lane];
                    const float ls = fminf(z, 0.f) - log1pf(expf(-fabsf(z)));
                    const int b = m / SEQ, s_ = m - b * SEQ; logf[((size_t)b * 6 + F.lane) * SEQ + s_] = ls; }
            }
        }
    }
    if constexpr (FC) __syncthreads();
}
__device__ __forceinline__ void subnorm_phase(Frame& F, const Args& a, int l, const bf16* OA, bf16* HB) {
    const int gw = F.vcu * NWAVES + F.wave, NGW = F.G * NWAVES, lane = F.lane;
    const float d1 = wave_sum(a.lam_q1[l * 64 + lane] * a.lam_k1[l * 64 + lane]), d2 = wave_sum(a.lam_q2[l * 64 + lane] * a.lam_k2[l * 64 + lane]);
    const float lam_init = 0.8f - 0.6f * expf(-0.3f * (float)l);
    const float lam = (expf(d1) - expf(d2)) + lam_init, post = 1.0f - lam_init;
    const int hd = lane >> 4, c8 = (lane & 15) * 8;
    f32x4 gd0 = *(const GAS f32x4*)(a.g_diff_sub + l * 128 + c8), gd1 = *(const GAS f32x4*)(a.g_diff_sub + l * 128 + c8 + 4);
    f32x4 gs[3], gf[3];
#pragma unroll
    for (int j = 0; j < 3; ++j) { gs[j] = *(const GAS f32x4*)(a.g_sb_out + l * 768 + 4 * lane + 256 * j); gf[j] = *(const GAS f32x4*)(a.g_fox_out + l * 768 + 4 * lane + 256 * j); }
    for (int m = gw; m < M; m += NGW) {
        const v4u w1 = *(const GAS v4u*)(OA + (size_t)m * 1024 + hd * 256 + c8), w2 = *(const GAS v4u*)(OA + (size_t)m * 1024 + hd * 256 + 128 + c8);
        bf16* hr = HB + (size_t)m * DM;
        u32x2 sb[3], fx[3];
#pragma unroll
        for (int j = 0; j < 3; ++j) { sb[j] = *(const GAS u32x2*)(hr + 512 + 4 * lane + 256 * j); fx[j] = *(const GAS u32x2*)(hr + 1280 + 4 * lane + 256 * j); }
        float d[8];
        d[0] = bflo(w1.x) - lam * bflo(w2.x); d[1] = bfhi(w1.x) - lam * bfhi(w2.x); d[2] = bflo(w1.y) - lam * bflo(w2.y); d[3] = bfhi(w1.y) - lam * bfhi(w2.y);
        d[4] = bflo(w1.z) - lam * bflo(w2.z); d[5] = bfhi(w1.z) - lam * bfhi(w2.z); d[6] = bflo(w1.w) - lam * bflo(w2.w); d[7] = bfhi(w1.w) - lam * bfhi(w2.w);
        float s = 0.f;
#pragma unroll
        for (int k = 0; k < 8; ++k) s += d[k] * d[k];
        s += __shfl_xor(s, 1); s += __shfl_xor(s, 2); s += __shfl_xor(s, 4); s += __shfl_xor(s, 8);
        const float rd = post / sqrtf(s * (1.f / 128.f) + EPS);
        v4u od; od.x = pkbf(d[0] * rd * gd0.x, d[1] * rd * gd0.y); od.y = pkbf(d[2] * rd * gd0.z, d[3] * rd * gd0.w); od.z = pkbf(d[4] * rd * gd1.x, d[5] * rd * gd1.y); od.w = pkbf(d[6] * rd * gd1.z, d[7] * rd * gd1.w);
        *(GAS v4u*)(hr + hd * 128 + c8) = od;
        float ss = 0.f, sf = 0.f; f32x4 vs[3], vf[3];
#pragma unroll
        for (int j = 0; j < 3; ++j) { vs[j] = (f32x4){bflo(sb[j].x), bfhi(sb[j].x), bflo(sb[j].y), bfhi(sb[j].y)}; vf[j] = (f32x4){bflo(fx[j].x), bfhi(fx[j].x), bflo(fx[j].y), bfhi(fx[j].y)};
            ss += (vs[j].x * vs[j].x + vs[j].y * vs[j].y) + (vs[j].z * vs[j].z + vs[j].w * vs[j].w); sf += (vf[j].x * vf[j].x + vf[j].y * vf[j].y) + (vf[j].z * vf[j].z + vf[j].w * vf[j].w); }
        const float rs = 1.f / sqrtf(wave_sum(ss) * (1.f / 768.f) + EPS), rf = 1.f / sqrtf(wave_sum(sf) * (1.f / 768.f) + EPS);
#pragma unroll
        for (int j = 0; j < 3; ++j) { const f32x4 u = vs[j] * rs * gs[j], w = vf[j] * rf * gf[j];
            *(GAS u32x2*)(hr + 512 + 4 * lane + 256 * j) = (u32x2){pkbf(u.x, u.y), pkbf(u.z, u.w)}; *(GAS u32x2*)(hr + 1280 + 4 * lane + 256 * j) = (u32x2){pkbf(w.x, w.y), pkbf(w.z, w.w)}; }
    }
}
__device__ __forceinline__ int claim_unit(Frame& F, gu32* ctr) {
    LAS unsigned* slot = (LAS unsigned*)(F.lds + att::OFF_MISC);
    if (F.tid == 0) *slot = __hip_atomic_fetch_add(ctr, 1u, __ATOMIC_RELAXED, __HIP_MEMORY_SCOPE_AGENT);
    __syncthreads();
    const int v = (int)*slot;
    __syncthreads();
    return v;
}

__global__ void __launch_bounds__(NWAVES * 64, 2) trunk_fwd(Args args) {
    extern __shared__ __attribute__((aligned(16))) unsigned char lds[];
    Frame F;
    F.lds = (LAS unsigned char*)lds;
    F.tid = threadIdx.x; F.lane = F.tid & 63; F.wave = __builtin_amdgcn_readfirstlane(F.tid >> 6);
    F.G = gridDim.x; { const int bx = blockIdx.x; F.vcu = (F.G % 8 == 0) ? (bx % 8) * (F.G / 8) + bx / 8 : bx; }
    unsigned char* ws = args.ws;
    gu32* ctl = (gu32*)(ws + WS_CTL);
    volatile LAS unsigned* MISC = (volatile LAS unsigned*)(F.lds + MISC_OFF);
    for (int u = F.tid; u < (LDS_BYTES - LDSCTL_OFF) / 4; u += NWAVES * 64) ((LAS unsigned*)(F.lds + LDSCTL_OFF))[u] = 0u;
    __syncthreads();
    XcdBarrier bar; bar.bar = (unsigned*)(ctl + CW_BAR); bar.x = 0; bar.st = nullptr;
    const int lo = args.ph_lo, hi = args.ph_hi;
    if (hi - lo > 1) bar = xcd_barrier_post((unsigned*)(ctl + CW_BAR), MISC + 8);
#define IN(k) (lo <= (k) && (k) < hi)
#define BOTH(k) (IN(k) && IN((k) + 1))
#define GRID_BAR() xcd_barrier(bar)
#define ALDS ((__attribute__((address_space(3))) char*)F.lds)
    bf16* HB = (bf16*)(ws + WS_HB); bf16* YB = (bf16*)(ws + WS_YB); bf16* PROJ = (bf16*)(ws + WS_BIG); bf16* OA = (bf16*)(ws + WS_OA);
    bf16* QX = (bf16*)(ws + WS_QX); bf16* O2 = (bf16*)(ws + WS_O2); bf16* HID = (bf16*)(ws + WS_BIG); bf16* KV = (bf16*)(ws + WS_KV);
    float* LOGF = (float*)(ws + WS_LOGF); const float* ROPE = (const float*)(ws + WS_ROPE);

    if (EN(0) && IN(0)) { PHASE_FENCE(F);
        p0_weights(F, args, ws);
        p0_rope(F, args, ws);
        p0_memn(F, args, ws);
        __syncthreads();
        row_phase<true>(F, nullptr, nullptr, args.x, nullptr, args.g_mix_pre, HB, args.w_in, args.b_f, LOGF);
        if (BOTH(0)) GRID_BAR();
    }
    for (int l = 0; l < DEPTH; ++l) {
        const int pb = 1 + 12 * l;
        unsigned char* wl = ws + WS_W + (size_t)l * W_LAYER;
        const float* xcur = (l == 0) ? args.x : args.out;
        if (EN(1) && IN(pb + 0)) { PHASE_FENCE(F);
            if (EN_G0 && l == 0) { pg8::Gemm g{(const bf16*)(ws + WS_MEMN), (const bf16*)(ws + WS_WCKV), DEPTH * MM, DEPTH * 1024, DM}; pg8::KvOrder S{F.G, (int)blockIdx.x};
                pg8::EpiStore E{KV, 1024, nullptr, 0, 3}; pg8::gemm_phase<pg8::EpiStore, pg8::KvOrder, true, true>(F.lds, g, S, E); }
            pg8::Gemm g{HB, (const bf16*)(wl + WO_IN), M, NPROJ, DM}; pg8::StaticOrder S; S.init(M, NPROJ, F.G, (int)blockIdx.x);
            pg8::EpiStore E{PROJ, NPROJ, ROPE, ROPE_TILES, -1}; pg8::gemm_phase<pg8::EpiStore, pg8::StaticOrder, true, true>(F.lds, g, S, E);
            if (BOTH(pb + 0)) GRID_BAR();
        }
        if (EN(2) && IN(pb + 1)) { PHASE_FENCE(F);
            gu32* q0 = ctl + CW_Q + 64 * (3 * l);
            if (EN_A1) for (;;) { const int u = claim_unit(F, q0); if (u >= 768) break; const int qb = 7 - u / 96, bh = u % 96, b = bh / 6, h = bh % 6;
                const size_t r0 = (size_t)b * SEQ; const int pos0 = qb * 256;
                att::attn_unit<1>(PROJ + (r0 + pos0) * NPROJ + QB_C + h * 128, NPROJ, PROJ + r0 * NPROJ + KB_C + h * 128, PROJ + r0 * NPROJ + VB_C + h * 128, NPROJ,
                                  HB + (r0 + pos0) * DM + 512 + h * 128, DM, pos0, 4 * (qb + 1), 0, nullptr, ALDS); }
            if (EN_A2) for (;;) { const int u = claim_unit(F, q0 + 64); if (u >= 768) break; const int qb = 7 - u / 96, bh = u % 96, b = bh / 6, h = bh % 6;
                const size_t r0 = (size_t)b * SEQ; const int pos0 = qb * 256;
                att::attn_unit<2>(PROJ + (r0 + pos0) * NPROJ + QC_C + h * 128, NPROJ, PROJ + r0 * NPROJ + KC_C + h * 128, PROJ + r0 * NPROJ + VC_C + h * 128, NPROJ,
                                  HB + (r0 + pos0) * DM + 1280 + h * 128, DM, pos0, 4 * (qb + 1), 0, LOGF + (size_t)bh * SEQ, ALDS); }
            if (EN_A0) for (;;) { const int u = claim_unit(F, q0 + 128); if (u >= 1024) break; const int qb = 7 - u / 128, bv = u % 128, b = bv / 8, vh = bv % 8, h = vh >> 1, jm = vh & 1;
                const size_t r0 = (size_t)b * SEQ; const int pos0 = qb * 256;
                att::attn_unit<0>(PROJ + (r0 + pos0) * NPROJ + QA_C + h * 128 + jm * 64, NPROJ, PROJ + r0 * NPROJ + KA_C + h * 128, PROJ + r0 * NPROJ + VA_C + h * 128, NPROJ,
                                  OA + (r0 + pos0) * 1024 + vh * 128, 1024, pos0, 4 * (qb + 1), jm * 128, nullptr, ALDS); }
            if (BOTH(pb + 1)) GRID_BAR();
        }
        if (EN(3) && IN(pb + 2)) { PHASE_FENCE(F); subnorm_phase(F, args, l, OA, HB); if (BOTH(pb + 2)) GRID_BAR(); }
        if (EN(4) && IN(pb + 3)) { PHASE_FENCE(F);
            pg8::Gemm g{HB, (const bf16*)(wl + WO_OUT), M, DM, DM}; pg8::StaticOrder S; S.init(M, DM, F.G, (int)blockIdx.x);
            pg8::EpiStore E{YB, DM, nullptr, 0, -1}; pg8::gemm_phase<pg8::EpiStore, pg8::StaticOrder, true, true>(F.lds, g, S, E);
            if (BOTH(pb + 3)) GRID_BAR();
        }
        if (EN(5) && IN(pb + 4)) { PHASE_FENCE(F); row_phase<false>(F, YB, args.g_mix_post + l * DM, xcur, args.out, args.g_x_pre + l * DM, HB, nullptr, nullptr, nullptr); if (BOTH(pb + 4)) GRID_BAR(); }
        if (EN(6) && IN(pb + 5)) { PHASE_FENCE(F);
            pg8::Gemm g{HB, (const bf16*)(wl + WO_CQ), M, CROSSW, DM}; pg8::StaticOrder S; S.init(M, CROSSW, F.G, (int)blockIdx.x);
            pg8::EpiStore E{QX, CROSSW, nullptr, 0, -1}; pg8::gemm_phase<pg8::EpiStore, pg8::StaticOrder, true, true>(F.lds, g, S, E);
            if (BOTH(pb + 5)) GRID_BAR();
        }
        if (EN(7) && IN(pb + 6)) { PHASE_FENCE(F);
            const bf16* kvl = KV + (size_t)l * MM * 1024;
            for (int u = blockIdx.x; u < BATCH * 4 * 8; u += F.G) { const int qb = u & 7, bh = u >> 3, b = bh >> 2, h = bh & 3; const size_t r0 = (size_t)b * SEQ + qb * 256;
                att::attn_unit<3>(QX + r0 * CROSSW + h * 128, CROSSW, kvl + (size_t)b * MEMLEN * 1024 + h * 128, kvl + (size_t)b * MEMLEN * 1024 + 512 + h * 128, 1024,
                                  O2 + r0 * CROSSW + h * 128, CROSSW, 0, 4, 0, nullptr, ALDS); }
            if (BOTH(pb + 6)) GRID_BAR();
        }
        if (EN(8) && IN(pb + 7)) { PHASE_FENCE(F);
            pg8::Gemm g{O2, (const bf16*)(wl + WO_CO), M, DM, CROSSW}; pg8::StaticOrder S; S.init(M, DM, F.G, (int)blockIdx.x);
            pg8::EpiStore E{YB, DM, nullptr, 0, -1}; pg8::gemm_phase<pg8::EpiStore, pg8::StaticOrder, true, true>(F.lds, g, S, E);
            if (BOTH(pb + 7)) GRID_BAR();
        }
        if (EN(9) && IN(pb + 8)) { PHASE_FENCE(F); row_phase<false>(F, YB, args.g_x_post + l * DM, args.out, args.out, args.g_ffn_pre + l * DM, HB, nullptr, nullptr, nullptr); if (BOTH(pb + 8)) GRID_BAR(); }
        if (EN(10) && IN(pb + 9)) { PHASE_FENCE(F);
            pg8::Gemm g{HB, (const bf16*)(wl + WO_GU), M, 2 * DFF, DM}; pg8::StaticOrder S; S.init(M, 2 * DFF, F.G, (int)blockIdx.x);
            pg8::EpiSwiGLU E{HID, DFF}; pg8::gemm_phase<pg8::EpiSwiGLU, pg8::StaticOrder, true, true>(F.lds, g, S, E);
            if (BOTH(pb + 9)) GRID_BAR();
        }
        if (EN(11) && IN(pb + 10)) { PHASE_FENCE(F);
            pg8::Gemm g{HID, (const bf16*)(wl + WO_DN), M, DM, DFF}; pg8::StaticOrder S; S.init(M, DM, F.G, (int)blockIdx.x);
            pg8::EpiStore E{YB, DM, nullptr, 0, -1}; pg8::gemm_phase<pg8::EpiStore, pg8::StaticOrder, true, true>(F.lds, g, S, E);
            if (BOTH(pb + 10)) GRID_BAR();
        }
        if (EN(12) && IN(pb + 11)) { PHASE_FENCE(F);
            if (l + 1 < DEPTH) row_phase<true>(F, YB, args.g_ffn_post + l * DM, args.out, args.out, args.g_mix_pre + (l + 1) * DM, HB, args.w_in + (size_t)(l + 1) * DM * INCOLS, args.b_f + (l + 1) * 6, LOGF);
            else row_phase<false>(F, YB, args.g_ffn_post + l * DM, args.out, args.out, nullptr, nullptr, nullptr, nullptr, nullptr);
            if (BOTH(pb + 11)) GRID_BAR();
        }
    }
#undef IN
#undef BOTH
#undef GRID_BAR
#undef ALDS
}

extern "C" void kernel_launch(void* const* d_in, const int* in_sizes, int n_in, void* d_out, int out_size, void* d_ws, size_t ws_size, hipStream_t stream) {
    static int grid = 0;
    if (grid == 0) {
        if (n_in != 26 || in_sizes[0] != M * DM || out_size != M * DM || ws_size < WS_END) { fprintf(stderr, "kernel_launch: unexpected shapes (n_in %d, in0 %d, out %d, ws %zu)\n", n_in, n_in > 0 ? in_sizes[0] : -1, out_size, ws_size); grid = -1; return; }
        int dev = 0, cus = 0, per_cu = 0;
        if (hipGetDevice(&dev) != hipSuccess || hipDeviceGetAttribute(&cus, hipDeviceAttributeMultiprocessorCount, dev) != hipSuccess) { grid = -1; return; }
        if (hipFuncSetAttribute((const void*)trunk_fwd, hipFuncAttributeMaxDynamicSharedMemorySize, LDS_BYTES) != hipSuccess) { fprintf(stderr, "kernel_launch: hipFuncSetAttribute failed\n"); grid = -1; return; }
        if (hipOccupancyMaxActiveBlocksPerMultiprocessor(&per_cu, (const void*)trunk_fwd, NWAVES * 64, LDS_BYTES) != hipSuccess || per_cu < 1) fprintf(stderr, "kernel_launch: occupancy query reports %d\n", per_cu);
        (void)hipGetLastError();
        grid = cus;
    }
    if (grid < 0) return;
    if (hipMemsetAsync((char*)d_ws + WS_CTL, 0, CTL_ZERO_BYTES, stream) != hipSuccess) return;
    Args a{};
    a.x = (const float*)d_in[0]; a.mem = (const float*)d_in[1]; a.pos = (const int*)d_in[2];
    a.g_mix_pre = (const float*)d_in[3]; a.g_mix_post = (const float*)d_in[4]; a.w_in = (const float*)d_in[5]; a.b_f = (const float*)d_in[6];
    a.lam_q1 = (const float*)d_in[7]; a.lam_k1 = (const float*)d_in[8]; a.lam_q2 = (const float*)d_in[9]; a.lam_k2 = (const float*)d_in[10];
    a.g_diff_sub = (const float*)d_in[11]; a.g_sb_out = (const float*)d_in[12]; a.g_fox_out = (const float*)d_in[13]; a.w_out = (const float*)d_in[14];
    a.g_x_pre = (const float*)d_in[15]; a.g_x_post = (const float*)d_in[16]; a.g_mem = (const float*)d_in[17]; a.w_cq = (const float*)d_in[18]; a.w_ckv = (const float*)d_in[19]; a.w_co = (const float*)d_in[20];
    a.g_ffn_pre = (const float*)d_in[21]; a.g_ffn_post = (const float*)d_in[22]; a.w_gate = (const float*)d_in[23]; a.w_up = (const float*)d_in[24]; a.w_down = (const float*)d_in[25];
    a.out = (float*)d_out; a.ws = (unsigned char*)d_ws;
#if MK_ONE_LAUNCH
    a.ph_lo = 0; a.ph_hi = N_PHASES; a.li = 0;
    hipLaunchKernelGGL(trunk_fwd, dim3(grid), dim3(NWAVES * 64), LDS_BYTES, stream, a);
#else
    for (int p = 0; p < N_PHASES; ++p) { a.ph_lo = p; a.ph_hi = p + 1; a.li = p;
        hipLaunchKernelGGL(trunk_fwd, dim3(grid), dim3(NWAVES * 64), LDS_BYTES, stream, a); }
#endif
}
```

```cpp
#include <hip/hip_runtime.h>
#include <hip/hip_bf16.h>
#include <cstdio>
#include <cstdint>
#include <cmath>
#define MK_ONE_LAUNCH 1
namespace pg8 {
#define PG8_LAS __attribute__((address_space(3)))
typedef unsigned short bf16_t;
typedef short bf16x8 __attribute__((ext_vector_type(8)));
typedef float f32x4 __attribute__((ext_vector_type(4)));
typedef unsigned u32x4 __attribute__((ext_vector_type(4)));
constexpr int BM = 256, BK = 64, HALF = 128, HTB = HALF * BK * 2  , STAGE_BYTES = 8 * HTB, NXCD = 8, WGM = 8;

__host__ __device__ __forceinline__ int lds_byte(int r, int c) { const int st = (r >> 4) * 2 + (c >> 5), rr = r & 15, cc = c & 31, ob = rr * 64 + cc * 2; return st * 1024 + (ob ^ (((ob >> 9) & 1) << 5)); }
__host__ __device__ __forceinline__ void stage_rc(int b, int& R, int& C) { const int st = b / 1024, sb = b % 1024, swz = sb ^ (((sb >> 9) & 1) << 5); R = (st >> 1) * 16 + swz / 64; C = (st & 1) * 32 + (swz % 64) / 2; }
__host__ __device__ __forceinline__ int perm32(int rho) { const int n = rho >> 4, i = rho & 15; return 8 * (i >> 2) + 4 * n + (i & 3); }

struct Unit { int pm, pn; };
struct Gemm { const bf16_t* A; const bf16_t* Bt; int M, N, K; };

struct StaticOrder {
    int nM, nN, nwg, G, c;
    __host__ __device__ void init(int M, int N, int G_, int c_) { nM = M / BM; nN = N / BM; nwg = nM * nN; G = G_; c = c_; }
    __host__ __device__ bool next(int i, Unit& u) const {
        const long L = (long)i * G + c; if (L >= nwg) return false;
        int wgid = (int)L; { const int q = nwg / NXCD, r = nwg % NXCD, xcd = wgid % NXCD, off = wgid / NXCD; wgid = (xcd < r ? xcd * (q + 1) : r * (q + 1) + (xcd - r) * q) + off; }
        const int nig = WGM * nN, gid = wgid / nig, fm = gid * WGM, gsz = (nM - fm) < WGM ? (nM - fm) : WGM;
        u.pm = fm + ((wgid % nig) % gsz); u.pn = (wgid % nig) / gsz; return true;
    }
    __device__ __forceinline__ void a_ready(const Unit&) const {}
    __device__ __forceinline__ void done(const Unit&) const {}
};

__device__ __forceinline__ unsigned cvt_pk_bf16(float lo, float hi) { unsigned r; asm volatile("v_cvt_pk_bf16_f32 %0, %1, %2" : "=v"(r) : "v"(lo), "v"(hi)); return r; }
typedef float f32x2 __attribute__((ext_vector_type(2)));
struct EpiStore {
    static constexpr bool PERM = true, AFTER_DRAIN = false;
    bf16_t* O; int ldc; const float* rope; int rope_tiles; int pn_mask;
    const float* rs;
    __device__ __forceinline__ void prefetch(const Unit& u, int wr, int fr, float (&epre)[8]) const {
        const int row0 = u.pm * BM + wr * 64 + fr;
#pragma unroll
        for (int i = 0; i < 8; ++i) epre[i] = rs ? rs[row0 + (i >> 2) * HALF + (i & 3) * 16] : 1.0f;
    }
    __device__ __forceinline__ void operator()(const f32x4 (&acc)[2][2][4][2], const Unit& u, int wr, int wc, int fr, int fq, const float (&epre)[8]) const {
        const int row0 = u.pm * BM + wr * 64 + fr; const int col0 = (u.pn & pn_mask) * BM + wc * 32 + 8 * fq;
        const bool do_rope = u.pn < rope_tiles;
#pragma unroll
        for (int ai = 0; ai < 2; ++ai)
#pragma unroll
            for (int m = 0; m < 4; ++m) { const int row = row0 + ai * HALF + m * 16; bf16_t* rowp = O + (size_t)row * ldc + col0;
                f32x4 cs0 = {1.f, 0.f, 1.f, 0.f}, cs1 = {1.f, 0.f, 1.f, 0.f}; const float rsc = epre[ai * 4 + m];
                if (do_rope) { const float* rp = rope + (size_t)row * 64 + (16 * (wc & 1) + 4 * fq) * 2; cs0 = *(const f32x4*)rp; cs1 = *(const f32x4*)(rp + 4); }
#pragma unroll
                for (int bj = 0; bj < 2; ++bj) { f32x4 v0 = acc[ai][bj][m][0] * rsc, v1 = acc[ai][bj][m][1] * rsc;
                    if (do_rope) {
                        f32x4 r0, r1;
                        r0[0] = v0[0] * cs0[0] - v0[1] * cs0[1]; r0[1] = v0[1] * cs0[0] + v0[0] * cs0[1];
                        r0[2] = v0[2] * cs0[2] - v0[3] * cs0[3]; r0[3] = v0[3] * cs0[2] + v0[2] * cs0[3];
                        r1[0] = v1[0] * cs1[0] - v1[1] * cs1[1]; r1[1] = v1[1] * cs1[0] + v1[0] * cs1[1];
                        r1[2] = v1[2] * cs1[2] - v1[3] * cs1[3]; r1[3] = v1[3] * cs1[2] + v1[2] * cs1[3];
                        v0 = r0; v1 = r1; }
                    u32x4 w; w.x = cvt_pk_bf16(v0[0], v0[1]); w.y = cvt_pk_bf16(v0[2], v0[3]); w.z = cvt_pk_bf16(v1[0], v1[1]); w.w = cvt_pk_bf16(v1[2], v1[3]);
                    *(u32x4*)(rowp + bj * HALF) = w; } }
    }
};
struct EpiSwiGLU {
    static constexpr bool PERM = true, AFTER_DRAIN = false;
    bf16_t* O; int ldc; const float* rs;
    __device__ __forceinline__ static float sw(float g, float up) { const float e = __builtin_amdgcn_exp2f(-1.4426950408889634f * g); return g * up * __builtin_amdgcn_rcpf(1.0f + e); }
    __device__ __forceinline__ void prefetch(const Unit& u, int wr, int fr, float (&epre)[8]) const {
        const int row0 = u.pm * BM + wr * 64 + fr;
#pragma unroll
        for (int i = 0; i < 8; ++i) epre[i] = rs[row0 + (i >> 2) * HALF + (i & 3) * 16];
    }
    __device__ __forceinline__ void operator()(const f32x4 (&acc)[2][2][4][2], const Unit& u, int wr, int wc, int fr, int fq, const float (&epre)[8]) const {
        const int row0 = u.pm * BM + wr * 64 + fr; const int col0 = u.pn * HALF + wc * 32 + 8 * fq;
#pragma unroll
        for (int ai = 0; ai < 2; ++ai)
#pragma unroll
            for (int m = 0; m < 4; ++m) { const int row = row0 + ai * HALF + m * 16; bf16_t* rowp = O + (size_t)row * ldc + col0;
                const float rsc = epre[ai * 4 + m];
                const f32x4 g0 = acc[ai][0][m][0] * rsc, g1 = acc[ai][0][m][1] * rsc, u0 = acc[ai][1][m][0] * rsc, u1 = acc[ai][1][m][1] * rsc;
                u32x4 w; w.x = cvt_pk_bf16(sw(g0[0], u0[0]), sw(g0[1], u0[1])); w.y = cvt_pk_bf16(sw(g0[2], u0[2]), sw(g0[3], u0[3]));
                w.z = cvt_pk_bf16(sw(g1[0], u1[0]), sw(g1[1], u1[1])); w.w = cvt_pk_bf16(sw(g1[2], u1[2]), sw(g1[3], u1[3]));
                *(u32x4*)rowp = w; }
    }
};
struct ClassOrder {
    int nM, nN, NC, rk;
    __host__ __device__ void init(int M, int N, int NC_, int rk_) { nM = M / BM; nN = N / BM; NC = NC_; rk = rk_; }
    __host__ __device__ bool next(int i, Unit& u) const { const int L = i * NC + rk; if (L >= nM * nN) return false;
        const int per = 8 * nN, g = L / per, r = L - g * per, gs = (nM - 8 * g) < 8 ? (nM - 8 * g) : 8; u.pm = 8 * g + r % gs; u.pn = r / gs; return true; }
    __device__ __forceinline__ void a_ready(const Unit&) const {}
    __device__ __forceinline__ void done(const Unit&) const {}
};
struct KvOrder {
    int T, NC, rk;
    __host__ __device__ bool next(int i, Unit& u) const { const int per = 4 * T, L = i * NC + rk; if (L >= 4 * per) return false; const int l = L / per, r = L - l * per;
        u.pm = l * T + (r >> 2); u.pn = 4 * l + (r & 3); return true; }
    __device__ __forceinline__ void a_ready(const Unit&) const {}
    __device__ __forceinline__ void done(const Unit&) const {}
};
#ifndef GEMM_DMA_IN_MMA
#define GEMM_DMA_IN_MMA 0
#endif
#ifndef GEMM_XMFMA
#define GEMM_XMFMA 0
#endif
template <class Epi, class Sched, bool ALIGN_EPI = false, bool SP2 = false>
__device__ __forceinline__ void gemm_phase(PG8_LAS unsigned char* lds, const Gemm g, const Sched& S, const Epi& E) {
    int tid_ = threadIdx.x; asm volatile("" : "+v"(tid_));
    const int tid = tid_, wid = __builtin_amdgcn_readfirstlane(tid >> 6), lane = tid & 63, wr = wid >> 2, wc = wid & 3, fr = lane & 15, fq = lane >> 4;
    constexpr bool DMA_IN_MMA = SP2 && (GEMM_DMA_IN_MMA != 0);
    const int K = g.K, nt = K / BK;
    unsigned voffA[2], voffB[2];
#pragma unroll
    for (int i = 0; i < 2; ++i) { int R, C; stage_rc(tid * 16 + i * 8192, R, C); const int Rb = Epi::PERM ? ((R & ~31) + perm32(R & 31)) : R;
        voffA[i] = (unsigned)(R * K + C) * 2u; voffB[i] = (unsigned)(Rb * K + C) * 2u; }
    const size_t kstep = (size_t)(BK * 2);
    const size_t hstep = (size_t)HALF * K * 2;
    const size_t tstep = 2 * hstep;
    const unsigned ldsw = (unsigned)wid * 1024u;
    const int aoff = lds_byte(wr * 64 + fr, fq * 8), boff = lds_byte(wc * 32 + fr, fq * 8);
#define PG8_SA(b, h) (((b) * 2 + (h)) * HTB)
#define PG8_SB(b, h) ((4 + (b) * 2 + (h)) * HTB)
#define PG8_STAGE(bufoff, gbase, voff) do { _Pragma("unroll") for (int _i = 0; _i < 2; ++_i) \
        __builtin_amdgcn_global_load_lds((const unsigned*)((const char*)(gbase) + (voff)[_i]), (PG8_LAS unsigned*)(lds + (bufoff) + ldsw + _i * 8192), 16, 0, 0); } while (0)
#define PG8_LDA(dst, b, h) do { _Pragma("unroll") for (int m = 0; m < 4; ++m) _Pragma("unroll") for (int k = 0; k < 2; ++k) dst[m][k] = *(const PG8_LAS bf16x8*)(lds + PG8_SA(b, h) + aoff + m * 2048 + k * 1024); } while (0)
#define PG8_LDB(dst, b, h) do { _Pragma("unroll") for (int n = 0; n < 2; ++n) _Pragma("unroll") for (int k = 0; k < 2; ++k) dst[n][k] = *(const PG8_LAS bf16x8*)(lds + PG8_SB(b, h) + boff + n * 2048 + k * 1024); } while (0)
#define PG8_MMA(ai, bj, At, Bt) do { __builtin_amdgcn_s_setprio(1); _Pragma("unroll") for (int m = 0; m < 4; ++m) _Pragma("unroll") for (int n = 0; n < 2; ++n) _Pragma("unroll") for (int k = 0; k < 2; ++k) \
        acc[ai][bj][m][n] = __builtin_amdgcn_mfma_f32_16x16x32_bf16(Bt[n][k], At[m][k], acc[ai][bj][m][n], 0, 0, 0); \
        if (GEMM_XMFMA) { bf16x8 z_ = {0, 0, 0, 0, 0, 0, 0, 0}; asm volatile("" : "+v"(z_)); _Pragma("unroll") for (int m = 0; m < 4; ++m) _Pragma("unroll") for (int n = 0; n < 2; ++n) acc[ai][bj][m][n] = __builtin_amdgcn_mfma_f32_16x16x32_bf16(z_, At[m][0], acc[ai][bj][m][n], 0, 0, 0); } \
        __builtin_amdgcn_s_setprio(0); } while (0)
#define PG8_WAIT_V(n) asm volatile("s_waitcnt vmcnt(" #n ")" ::: "memory")
#define PG8_WAIT_L(n) asm volatile("s_waitcnt lgkmcnt(" #n ")" ::: "memory")
#define PG8_BAR __builtin_amdgcn_s_barrier()
#define PG8_SCHED __builtin_amdgcn_sched_barrier(0)
    Unit cur, nxt; int ui = 0; float epre[8];
    if (!S.next(0, cur)) return;
    f32x4 acc[2][2][4][2];
#pragma unroll
    for (int a = 0; a < 2; ++a)
#pragma unroll
        for (int b = 0; b < 2; ++b)
#pragma unroll
            for (int m = 0; m < 4; ++m)
#pragma unroll
                for (int n = 0; n < 2; ++n) acc[a][b][m][n] = (f32x4){0.f, 0.f, 0.f, 0.f};
    bf16x8 At[4][2], B0[2][2], B1[2][2];
    const char* cA = (const char*)g.A + (size_t)cur.pm * tstep; const char* cB = (const char*)g.Bt + (size_t)cur.pn * tstep;
    S.a_ready(cur);
    E.prefetch(cur, wr, fr, epre);
    if constexpr (SP2) {
        PG8_STAGE(PG8_SB(0, 0), cB, voffB); PG8_STAGE(PG8_SB(0, 1), cB + hstep, voffB); PG8_STAGE(PG8_SA(0, 0), cA, voffA); PG8_STAGE(PG8_SA(0, 1), cA + hstep, voffA);
        if (wr == 1) PG8_BAR;
        PG8_WAIT_V(2); PG8_BAR;
        PG8_STAGE(PG8_SB(1, 0), cB + kstep, voffB); PG8_STAGE(PG8_SA(1, 0), cA + kstep, voffA); PG8_STAGE(PG8_SB(1, 1), cB + hstep + kstep, voffB);
        PG8_WAIT_V(6); PG8_BAR;
    } else {
        PG8_STAGE(PG8_SB(0, 0), cB, voffB); PG8_STAGE(PG8_SA(0, 0), cA, voffA); PG8_STAGE(PG8_SB(0, 1), cB + hstep, voffB); PG8_STAGE(PG8_SA(0, 1), cA + hstep, voffA);
        if (wr == 1) PG8_BAR;
        PG8_WAIT_V(4); PG8_BAR;
        PG8_STAGE(PG8_SB(1, 0), cB + kstep, voffB); PG8_STAGE(PG8_SA(1, 0), cA + kstep, voffA); PG8_STAGE(PG8_SB(1, 1), cB + hstep + kstep, voffB);
        PG8_WAIT_V(6); PG8_BAR;
    }
    for (;;) {
        const bool has_next = S.next(ui + 1, nxt);
        const char* nA = has_next ? (const char*)g.A + (size_t)nxt.pm * tstep : cA; const char* nB = has_next ? (const char*)g.Bt + (size_t)nxt.pn * tstep : cB;
        for (int t = 0; t < nt; t += 2) {
            const bool last = (t == nt - 2);
            const char* a1 = cA + (size_t)(t + 1) * kstep;
            const char* a2 = last ? nA : cA + (size_t)(t + 2) * kstep; const char* b2 = last ? nB : cB + (size_t)(t + 2) * kstep;
            const char* a3 = a2 + kstep; const char* b3 = b2 + kstep;
            if (last && has_next) S.a_ready(nxt);
            if constexpr (SP2) {
            PG8_LDB(B0, 0, 0); PG8_LDB(B1, 0, 1); PG8_SCHED; PG8_LDA(At, 0, 0); PG8_STAGE(PG8_SA(1, 1), a1 + hstep, voffA);
            PG8_WAIT_V(8); PG8_WAIT_L(0); PG8_BAR; PG8_MMA(0, 0, At, B0); PG8_MMA(0, 1, At, B1); PG8_BAR; PG8_SCHED;
            if constexpr (DMA_IN_MMA) {
            PG8_LDA(At, 0, 1);
            PG8_WAIT_V(2); PG8_WAIT_L(0); PG8_BAR; PG8_STAGE(PG8_SB(0, 0), b2, voffB); PG8_SCHED; PG8_MMA(1, 0, At, B0); PG8_SCHED; PG8_STAGE(PG8_SB(0, 1), b2 + hstep, voffB); PG8_SCHED; PG8_MMA(1, 1, At, B1); PG8_SCHED; PG8_STAGE(PG8_SA(0, 0), a2, voffA); PG8_BAR; PG8_SCHED;
            } else {
            PG8_LDA(At, 0, 1); PG8_STAGE(PG8_SB(0, 0), b2, voffB); PG8_STAGE(PG8_SB(0, 1), b2 + hstep, voffB); PG8_STAGE(PG8_SA(0, 0), a2, voffA);
            PG8_WAIT_V(8); PG8_WAIT_L(0); PG8_BAR; PG8_MMA(1, 0, At, B0); PG8_MMA(1, 1, At, B1); PG8_BAR; PG8_SCHED;
            }
            PG8_LDB(B0, 1, 0); PG8_LDB(B1, 1, 1); PG8_SCHED; PG8_LDA(At, 1, 0); PG8_STAGE(PG8_SA(0, 1), a2 + hstep, voffA);
            PG8_WAIT_V(8); PG8_WAIT_L(0); PG8_BAR; PG8_MMA(0, 0, At, B0); PG8_MMA(0, 1, At, B1); PG8_BAR; PG8_SCHED;
            if constexpr (DMA_IN_MMA) {
            PG8_LDA(At, 1, 1);
            PG8_WAIT_V(2); PG8_WAIT_L(0); PG8_BAR; PG8_STAGE(PG8_SB(1, 0), b3, voffB); PG8_SCHED; PG8_MMA(1, 0, At, B0); PG8_SCHED; PG8_STAGE(PG8_SB(1, 1), b3 + hstep, voffB); PG8_SCHED; PG8_MMA(1, 1, At, B1); PG8_SCHED; PG8_STAGE(PG8_SA(1, 0), a3, voffA); PG8_BAR; PG8_SCHED;
            } else {
            PG8_LDA(At, 1, 1); PG8_STAGE(PG8_SB(1, 0), b3, voffB); PG8_STAGE(PG8_SB(1, 1), b3 + hstep, voffB); PG8_STAGE(PG8_SA(1, 0), a3, voffA);
            PG8_WAIT_V(8); PG8_WAIT_L(0); PG8_BAR; PG8_MMA(1, 0, At, B0); PG8_MMA(1, 1, At, B1); PG8_BAR; PG8_SCHED;
            }
            } else {
            PG8_LDB(B0, 0, 0); PG8_SCHED; PG8_LDA(At, 0, 0); PG8_STAGE(PG8_SA(1, 1), a1 + hstep, voffA);
            PG8_WAIT_L(8); PG8_BAR; PG8_WAIT_L(0); PG8_MMA(0, 0, At, B0); PG8_BAR; PG8_SCHED;
            PG8_LDB(B1, 0, 1); PG8_STAGE(PG8_SB(0, 0), b2, voffB);
            PG8_BAR; PG8_WAIT_L(0); PG8_MMA(0, 1, At, B1); PG8_BAR;
            PG8_LDA(At, 0, 1); PG8_STAGE(PG8_SA(0, 0), a2, voffA);
            PG8_BAR; PG8_WAIT_L(0); PG8_MMA(1, 0, At, B0); PG8_BAR; PG8_SCHED;
            PG8_STAGE(PG8_SB(0, 1), b2 + hstep, voffB);
            PG8_WAIT_V(6); PG8_BAR; PG8_MMA(1, 1, At, B1); PG8_BAR;
            PG8_LDB(B0, 1, 0); PG8_SCHED; PG8_LDA(At, 1, 0); PG8_STAGE(PG8_SA(0, 1), a2 + hstep, voffA);
            PG8_WAIT_L(8); PG8_BAR; PG8_WAIT_L(0); PG8_MMA(0, 0, At, B0); PG8_BAR; PG8_SCHED;
            PG8_LDB(B1, 1, 1); PG8_STAGE(PG8_SB(1, 0), b3, voffB);
            PG8_BAR; PG8_WAIT_L(0); PG8_MMA(0, 1, At, B1); PG8_BAR;
            PG8_LDA(At, 1, 1); PG8_STAGE(PG8_SA(1, 0), a3, voffA);
            PG8_BAR; PG8_WAIT_L(0); PG8_MMA(1, 0, At, B0); PG8_BAR; PG8_SCHED;
            PG8_STAGE(PG8_SB(1, 1), b3 + hstep, voffB);
            PG8_WAIT_V(6); PG8_BAR; PG8_MMA(1, 1, At, B1); PG8_BAR;
            }
        }
        if constexpr (ALIGN_EPI) { if (wr == 0) PG8_BAR; }
        if constexpr (!Epi::AFTER_DRAIN) { E(acc, cur, wr, wc, fr, fq, epre); S.done(cur); }
        if (!has_next) break;
#pragma unroll
        for (int a = 0; a < 2; ++a)
#pragma unroll
            for (int b = 0; b < 2; ++b)
#pragma unroll
                for (int m = 0; m < 4; ++m)
#pragma unroll
                    for (int n = 0; n < 2; ++n) acc[a][b][m][n] = (f32x4){0.f, 0.f, 0.f, 0.f};
        cur = nxt; cA = nA; cB = nB; ++ui;
        E.prefetch(cur, wr, fr, epre);
        if constexpr (ALIGN_EPI) { if (wr == 1) PG8_BAR; }
    }
    PG8_WAIT_V(0);
    if constexpr (!ALIGN_EPI) { if (wr == 0) PG8_BAR; }
    PG8_BAR;
    if constexpr (Epi::AFTER_DRAIN) { E.fused(acc, cur, wr, wc, fr, fq, lds, wid, lane); S.done(cur); }
#undef PG8_SA
#undef PG8_SB
#undef PG8_STAGE
#undef PG8_LDA
#undef PG8_LDB
#undef PG8_MMA
#undef PG8_WAIT_V
#undef PG8_WAIT_L
#undef PG8_BAR
#undef PG8_SCHED
}
}
namespace att {
#ifndef ATT_XMFMA
#define ATT_XMFMA 0
#endif
#ifndef ATT_STAGGER
#define ATT_STAGGER 0
#endif
#ifndef ATT_XBAR
#define ATT_XBAR 0
#endif
#define ALAS __attribute__((address_space(3)))
typedef short bf16x8 __attribute__((ext_vector_type(8)));
typedef short s16x4 __attribute__((ext_vector_type(4)));
typedef float f32x16 __attribute__((ext_vector_type(16)));
typedef float f32x4 __attribute__((ext_vector_type(4)));
typedef unsigned u32x4 __attribute__((ext_vector_type(4)));
typedef unsigned short bf16_t;
constexpr int NW = 8, QBLK = 32, KVBLK = 64, QB = NW * QBLK;
constexpr int SHM_V = KVBLK * 128 * 2, SHM_K = KVBLK * 128 * 2;
constexpr int OFF_V = 0, OFF_K = 2 * SHM_V, OFF_WS = OFF_K + 2 * SHM_K, OFF_CUM = OFF_WS + NW * 64 * 4, OFF_MISC = OFF_CUM + 2048 * 4, ATT_LDS_BYTES = OFF_MISC + 256;
constexpr float LOG2E = 1.4426950408889634f;
#define KSWZ(row, colB) ((row) * 256 + ((colB) ^ (((row) & 7) << 4)))
#define SBAR() __builtin_amdgcn_sched_barrier(0)
__device__ __forceinline__ int v_st(int k, int c) { const int kk = (k & ~0xC) | ((k & 4) << 1) | ((k & 8) >> 1); return ((kk >> 3) * 4 + (c >> 5)) * 512 + ((kk & 7) * 32 + (c & 31)) * 2; }
__device__ __forceinline__ int v_rd_base(int lane) { return ((lane & 3) << 3) | (((lane >> 2) & 3) << 6) | (((lane >> 4) & 1) << 5) | (((lane >> 5) & 1) << 8); }
constexpr int v_rd_off(int d0, int ks, int half) { return d0 * 512 + ks * 4096 + half * 2048; }
__device__ __forceinline__ int crow(int r, int hi) { return (r & 3) + 8 * (r >> 2) + 4 * hi; }
__device__ __forceinline__ unsigned cvtpk(float lo, float hi) { unsigned r; asm volatile("v_cvt_pk_bf16_f32 %0, %1, %2" : "=v"(r) : "v"(lo), "v"(hi)); return r; }
__device__ __forceinline__ void mask_tile(f32x16& p0, f32x16& p1, int dq) {
    const float NEG = -__builtin_inff();
#pragma unroll
    for (int r = 0; r < 16; ++r) { const int c = (r & 3) + 8 * (r >> 2);
        if (dq - c < 0) p0[r] = NEG;
        if (dq - c - 32 < 0) p1[r] = NEG; }
}
__device__ __forceinline__ void pack_p(const f32x16& p0, const f32x16& p1, bf16x8& pa0, bf16x8& pa1, bf16x8& pa2, bf16x8& pa3) {
#define PK4(P, B_, OUT) do { unsigned a0 = cvtpk(P[B_+0], P[B_+1]), a1 = cvtpk(P[B_+2], P[B_+3]); unsigned b0 = cvtpk(P[B_+4], P[B_+5]), b1 = cvtpk(P[B_+6], P[B_+7]); \
        auto r0 = __builtin_amdgcn_permlane32_swap(a0, b0, false, false); auto r1 = __builtin_amdgcn_permlane32_swap(a1, b1, false, false); \
        u32x4 w = {r0[0], r1[0], r0[1], r1[1]}; OUT = __builtin_bit_cast(bf16x8, w); } while (0)
    PK4(p0, 0, pa0); PK4(p0, 8, pa1); PK4(p1, 0, pa2); PK4(p1, 8, pa3);
#undef PK4
}
template <int KB, int ND>
__device__ __forceinline__ void qkt(f32x16& p0, f32x16& p1, const ALAS char* K_lds, int r32, int hi, const bf16x8* qr, int koff) {
    p0 = f32x16{}; p1 = f32x16{};
    const ALAS char* kb[4];
#pragma unroll
    for (int dd = 0; dd < 4; ++dd) kb[dd] = K_lds + KB * SHM_K + KSWZ(r32, (dd * 16 + hi * 8) * 2) + koff;
#pragma unroll
    for (int d0 = 0; d0 < ND; ++d0) { const ALAS char* a = kb[d0 & 3] + (d0 >> 2) * 128;
        const bf16x8 b0 = *(const ALAS bf16x8*)(a);
        const bf16x8 b1 = *(const ALAS bf16x8*)(a + 32 * 256);
        p0 = __builtin_amdgcn_mfma_f32_32x32x16_bf16(b0, qr[d0], p0, 0, 0, 0);
        p1 = __builtin_amdgcn_mfma_f32_32x32x16_bf16(b1, qr[d0], p1, 0, 0, 0);
        if (ATT_XMFMA && d0 < 4) { bf16x8 z = {0, 0, 0, 0, 0, 0, 0, 0}; asm volatile("" : "+v"(z));
            p0 = __builtin_amdgcn_mfma_f32_32x32x16_bf16(b0, z, p0, 0, 0, 0); p1 = __builtin_amdgcn_mfma_f32_32x32x16_bf16(b1, z, p1, 0, 0, 0); } }
}
template <int VB>
__device__ __forceinline__ void pv_tile(f32x16* o, int vb0, bf16x8 pa0, bf16x8 pa1, bf16x8 pa2, bf16x8 pa3) {
#define TRRD(dst, off) asm volatile("ds_read_b64_tr_b16 %0, %1 offset:%2" : "=&v"(dst) : "v"(vb0), "i"(off) : "memory")
#define PV_D0(d0) do { s16x4 l0, l1, l2, l3, h0, h1, h2, h3; constexpr int b_ = VB * SHM_V + v_rd_off(d0, 0, 0); \
        TRRD(l0, b_); TRRD(h0, b_ + 2048); TRRD(l1, b_ + 4096); TRRD(h1, b_ + 6144); TRRD(l2, b_ + 8192); TRRD(h2, b_ + 10240); TRRD(l3, b_ + 12288); TRRD(h3, b_ + 14336); \
        asm volatile("s_waitcnt lgkmcnt(0)" ::: "memory"); SBAR(); \
        o[d0] = __builtin_amdgcn_mfma_f32_32x32x16_bf16(pa0, (bf16x8){l0[0], l0[1], l0[2], l0[3], h0[0], h0[1], h0[2], h0[3]}, o[d0], 0, 0, 0); \
        o[d0] = __builtin_amdgcn_mfma_f32_32x32x16_bf16(pa1, (bf16x8){l1[0], l1[1], l1[2], l1[3], h1[0], h1[1], h1[2], h1[3]}, o[d0], 0, 0, 0); \
        o[d0] = __builtin_amdgcn_mfma_f32_32x32x16_bf16(pa2, (bf16x8){l2[0], l2[1], l2[2], l2[3], h2[0], h2[1], h2[2], h2[3]}, o[d0], 0, 0, 0); \
        o[d0] = __builtin_amdgcn_mfma_f32_32x32x16_bf16(pa3, (bf16x8){l3[0], l3[1], l3[2], l3[3], h3[0], h3[1], h3[2], h3[3]}, o[d0], 0, 0, 0); } while (0)
    PV_D0(0); PV_D0(1); PV_D0(2); PV_D0(3);
#undef PV_D0
#undef TRRD
}
__device__ __forceinline__ float swap_max(float v) { auto rr = __builtin_amdgcn_permlane32_swap(__float_as_uint(v), __float_as_uint(v), false, false); return fmaxf(__uint_as_float(rr[0]), __uint_as_float(rr[1])); }
__device__ __forceinline__ float swap_sum(float v) { auto rr = __builtin_amdgcn_permlane32_swap(__float_as_uint(v), __float_as_uint(v), false, false); return __uint_as_float(rr[0]) + __uint_as_float(rr[1]); }

__device__ __forceinline__ void store_o(const f32x16* o, const float* rli, bf16_t* Ow, int op, ALAS char* lds, int wid, int lane, int r32, int hi) {
    __syncthreads();
    ALAS char* stg = lds + wid * 8192;
#pragma unroll
    for (int r = 0; r < 16; ++r) { const int orow = crow(r, hi);
#pragma unroll
        for (int d0 = 0; d0 < 4; ++d0) { const float v = o[d0][r] * rli[r]; const float vn = __shfl_xor(v, 1);
            if ((r32 & 1) == 0) *(ALAS unsigned*)(stg + orow * 256 + (d0 * 32 + r32) * 2) = cvtpk(v, vn); } }
    asm volatile("s_waitcnt lgkmcnt(0)" ::: "memory");
#pragma unroll
    for (int i = 0; i < 8; ++i) { const int row = i * 4 + (lane >> 4), ch = lane & 15; const u32x4 v = *(const ALAS u32x4*)(stg + row * 256 + ch * 16); *(u32x4*)(Ow + (size_t)row * op + ch * 8) = v; }
    __syncthreads();
}
template <int MODE>
__device__ __forceinline__ void attn_unit(const bf16_t* Q, int qp, const bf16_t* K, const bf16_t* V, int kvp, bf16_t* O, int op, int pos0, int NT, int koff, const float* logf, ALAS char* lds) {
    constexpr int ND = (MODE == 0) ? 4 : 8;
    constexpr bool CAUSAL = (MODE != 3), SB = (MODE == 1);
    constexpr float SCALE = (MODE == 0) ? 0.125f : 0.08838834764831845f;
    constexpr float C2 = SCALE * LOG2E;
    constexpr float THR2 = 8.f * LOG2E;
    int tid_ = threadIdx.x; asm volatile("" : "+v"(tid_));
    const int tid = tid_, wid = __builtin_amdgcn_readfirstlane(tid >> 6), lane = tid & 63, r32 = lane & 31, hi = lane >> 5;
    const ALAS char* V_lds = lds + OFF_V; const ALAS char* K_lds = lds + OFF_K;
    ALAS float* wsf = (ALAS float*)(lds + OFF_WS) + wid * 64; ALAS float* li_l = wsf; ALAS float* al_l = wsf + 32;
    ALAS float* cum2 = (ALAS float*)(lds + OFF_CUM);
    const int sr = tid >> 4, sc = (tid & 15) * 8, vst0 = v_st(sr, sc), vst1 = v_st(32 + sr, sc), kws = KSWZ(sr, sc * 2);
    const int vb0 = (int)(uintptr_t)(V_lds) + v_rd_base(lane);
    float cq2 = 0.f;
    if constexpr (MODE == 2) {
        const f32x4 v = *(const f32x4*)(logf + 4 * tid);
        const float a0 = v[0], a1 = a0 + v[1], a2 = a1 + v[2], a3 = a2 + v[3];
        float s = a3;
#pragma unroll
        for (int off = 1; off < 64; off <<= 1) { const float t = __shfl_up(s, off); if (lane >= off) s += t; }
        ALAS float* wt = (ALAS float*)(lds + OFF_MISC) + 16;
        if (lane == 63) wt[wid] = s;
        __syncthreads();
        float base = 0.f;
#pragma unroll
        for (int w = 0; w < NW; ++w) { const float t = wt[w]; if (w < wid) base += t; }
        const float ex = s - a3 + base;
        f32x4 c; c[0] = (ex + a0) * LOG2E; c[1] = (ex + a1) * LOG2E; c[2] = (ex + a2) * LOG2E; c[3] = (ex + a3) * LOG2E;
        *(ALAS f32x4*)(cum2 + 4 * tid) = c;
        __syncthreads();
        cq2 = cum2[pos0 + wid * QBLK + r32];
    }
    bf16x8 qr[ND];
#pragma unroll
    for (int d0 = 0; d0 < ND; ++d0) qr[d0] = *(const bf16x8*)(Q + (size_t)(wid * QBLK + r32) * qp + d0 * 16 + hi * 8);
    const int qlo = pos0 + wid * QBLK;
    const int qm = pos0 + wid * QBLK + r32 - 4 * hi - (SB ? 1 : 0);
    float m_reg = -1e30f, l_reg = 0.f, carry = 0.f; f32x16 o[4] = {};
    bf16x8 st_k0, st_k1, st_v0, st_v1;
#define TILE_OF(it) (SB ? (NT - 1 - (it)) : (it))
#define GROW(p, k0, rr) ((p) + (size_t)((k0) + (rr)) * kvp + sc)
#define SLOAD(k0) do { st_v0 = *(const bf16x8*)GROW(V, k0, sr); st_v1 = *(const bf16x8*)GROW(V, k0, 32 + sr); st_k0 = *(const bf16x8*)GROW(K, k0, sr); st_k1 = *(const bf16x8*)GROW(K, k0, 32 + sr); } while (0)
#define SWRITE(bf) do { *(ALAS bf16x8*)(lds + OFF_K + (bf) * SHM_K + kws) = st_k0; *(ALAS bf16x8*)(lds + OFF_K + (bf) * SHM_K + kws + 32 * 256) = st_k1; \
                        *(ALAS bf16x8*)(lds + OFF_V + (bf) * SHM_V + vst0) = st_v0; *(ALAS bf16x8*)(lds + OFF_V + (bf) * SHM_V + vst1) = st_v1; } while (0)
    SLOAD(TILE_OF(0) * KVBLK); SWRITE(0);
    __syncthreads();
    f32x16 p0, p1; bf16x8 pa0, pa1, pa2, pa3; bool wdone = false, stop = false;
    ALAS unsigned* dflag = (ALAS unsigned*)(lds + OFF_MISC + 128);
#define STEP(it, BUF) do { \
        const int kb_ = TILE_OF(it) * KVBLK; \
        if ((it) + 1 < NT) SLOAD(TILE_OF((it) + 1) * KVBLK); \
          \
        const bool act_ = SB ? (kb_ < qlo + QBLK - 1 && !wdone) : (CAUSAL ? (kb_ <= qlo + QBLK - 1) : true); \
        if (act_) { \
        SBAR(); qkt<BUF, ND>(p0, p1, K_lds, r32, hi, qr, koff); SBAR(); \
        if constexpr (SB) { \
            _Pragma("unroll") for (int r = 0; r < 16; ++r) { p0[r] *= C2; p1[r] *= C2; } \
            if (kb_ + KVBLK - 1 > qlo - 1) mask_tile(p0, p1, qm - kb_); \
            float G0[4], G1[4]; \
            _Pragma("unroll") for (int g = 0; g < 4; ++g) { float s0 = 0.f, s1 = 0.f; \
                _Pragma("unroll") for (int k = 3; k >= 0; --k) { const int r = 4 * g + k; \
                    { const float z = p0[r]; const float sp = fmaxf(z, 0.f) + __builtin_amdgcn_logf(1.0f + __builtin_amdgcn_exp2f(-fabsf(z))); p0[r] = (z - sp) + s0; s0 -= sp; } \
                    { const float z = p1[r]; const float sp = fmaxf(z, 0.f) + __builtin_amdgcn_logf(1.0f + __builtin_amdgcn_exp2f(-fabsf(z))); p1[r] = (z - sp) + s1; s1 -= sp; } } \
                G0[g] = s0; G1[g] = s1; } \
            float run = carry; float offv[8]; \
            _Pragma("unroll") for (int b = 7; b >= 0; --b) { const float gsum = (b >= 4) ? G1[b - 4] : G0[b]; \
                auto rr = __builtin_amdgcn_permlane32_swap(__float_as_uint(gsum), __float_as_uint(gsum), false, false); \
                const float glo = __uint_as_float(rr[0]), ghi = __uint_as_float(rr[1]); \
                offv[b] = run + (hi == 0 ? ghi : 0.f); run += glo + ghi; } \
            carry = run; wdone = __all(carry < -152.0f);     \
            _Pragma("unroll") for (int r = 0; r < 16; ++r) { p0[r] = __builtin_amdgcn_exp2f(p0[r] + offv[r >> 2]); p1[r] = __builtin_amdgcn_exp2f(p1[r] + offv[4 + (r >> 2)]); } \
        } else { \
            if constexpr (MODE == 2) { \
                _Pragma("unroll") for (int g = 0; g < 4; ++g) { const f32x4 c0 = *(const ALAS f32x4*)(cum2 + kb_ + 8 * g + 4 * hi); const f32x4 c1 = *(const ALAS f32x4*)(cum2 + kb_ + 32 + 8 * g + 4 * hi); \
                    _Pragma("unroll") for (int k = 0; k < 4; ++k) { p0[4 * g + k] = fmaf(p0[4 * g + k], C2, cq2 - c0[k]); p1[4 * g + k] = fmaf(p1[4 * g + k], C2, cq2 - c1[k]); } } \
            } else { _Pragma("unroll") for (int r = 0; r < 16; ++r) { p0[r] *= C2; p1[r] *= C2; } } \
            if constexpr (CAUSAL) { if (kb_ + KVBLK - 1 > qlo) mask_tile(p0, p1, qm - kb_); } \
            float pmax = p0[0]; \
            _Pragma("unroll") for (int r = 1; r < 16; ++r) pmax = fmaxf(pmax, p0[r]); \
            _Pragma("unroll") for (int r = 0; r < 16; ++r) pmax = fmaxf(pmax, p1[r]); \
            pmax = swap_max(pmax); \
            float mn, alpha; \
            if (__all(pmax - m_reg <= THR2)) { mn = m_reg; alpha = 1.f; } \
            else { mn = fmaxf(m_reg, pmax); alpha = __builtin_amdgcn_exp2f(m_reg - mn); m_reg = mn; } \
            float ps = 0.f; \
            _Pragma("unroll") for (int r = 0; r < 16; ++r) { p0[r] = __builtin_amdgcn_exp2f(p0[r] - mn); p1[r] = __builtin_amdgcn_exp2f(p1[r] - mn); ps += p0[r] + p1[r]; } \
            ps = swap_sum(ps); l_reg = l_reg * alpha + ps; \
            if (__any(alpha < 1.f)) { if (hi == 0) al_l[r32] = alpha; asm volatile("s_waitcnt lgkmcnt(0)" ::: "memory"); \
                _Pragma("unroll") for (int d_ = 0; d_ < 4; ++d_) _Pragma("unroll") for (int r = 0; r < 16; ++r) o[d_][r] *= al_l[crow(r, hi)]; } \
        } \
        pack_p(p0, p1, pa0, pa1, pa2, pa3); SBAR(); \
        pv_tile<BUF>(o, vb0, pa0, pa1, pa2, pa3); SBAR(); \
        } \
        if ((it) + 1 < NT) SWRITE((BUF) ^ 1); \
        if constexpr (SB) { if (lane == 0) dflag[(BUF) * 8 + wid] = wdone ? 1u : 0u; } \
        __syncthreads(); \
        if constexpr (SB) { const u32x4 f0 = *(const ALAS u32x4*)(dflag + (BUF) * 8), f1 = *(const ALAS u32x4*)(dflag + (BUF) * 8 + 4); \
            stop = ((f0[0] & f0[1] & f0[2] & f0[3] & f1[0] & f1[1] & f1[2] & f1[3]) != 0u); } \
        } while (0)
    for (int it = 0; it < NT; it += 2) { STEP(it, 0); if (stop) break; STEP(it + 1, 1); if (stop) break; }
#undef STEP
#undef SWRITE
#undef SLOAD
#undef GROW
#undef TILE_OF
    float rli[16];
    if constexpr (SB) {
#pragma unroll
        for (int r = 0; r < 16; ++r) rli[r] = 1.f;
    } else {
        if (hi == 0) li_l[r32] = l_reg; asm volatile("s_waitcnt lgkmcnt(0)" ::: "memory");
#pragma unroll
        for (int r = 0; r < 16; ++r) rli[r] = __builtin_amdgcn_rcpf(li_l[crow(r, hi)]);
    }
    store_o(o, rli, O + (size_t)(wid * QBLK) * op, op, lds, wid, lane, r32, hi);
}

template <int MODE>
__device__ __forceinline__ void partialSM(f32x16& p0, f32x16& p1, float& m_reg, float& alpha) {
    constexpr float SCALE = (MODE == 0) ? 0.125f : 0.08838834764831845f;
    constexpr float CS = (MODE == 2) ? 1.0f : SCALE * LOG2E, THR2 = 8.f * LOG2E;
    float pmax = p0[0];
#pragma unroll
    for (int r = 1; r < 16; ++r) pmax = fmaxf(pmax, p0[r]);
#pragma unroll
    for (int r = 0; r < 16; ++r) pmax = fmaxf(pmax, p1[r]);
    pmax = swap_max(pmax);
    float mn;
    if (__builtin_expect(__all((pmax - m_reg) * CS <= THR2), 1)) { mn = m_reg; alpha = 1.f; }
    else { mn = fmaxf(m_reg, pmax); alpha = __builtin_amdgcn_exp2f((m_reg - mn) * CS); m_reg = mn; }
    const float mnL = -mn * CS;
#pragma unroll
    for (int r = 0; r < 16; ++r) { p0[r] = fmaf(p0[r], CS, mnL); p1[r] = fmaf(p1[r], CS, mnL); }
#pragma unroll
    for (int r = 0; r < 16; ++r) p0[r] = __builtin_amdgcn_exp2f(p0[r]);
}
__device__ __forceinline__ void finishSM(f32x16& p0, f32x16& p1, float alpha, float& l_reg, bf16x8& pa0, bf16x8& pa1, bf16x8& pa2, bf16x8& pa3) {
#pragma unroll
    for (int r = 0; r < 16; ++r) p1[r] = __builtin_amdgcn_exp2f(p1[r]);
    float ps = 0.f;
#pragma unroll
    for (int r = 0; r < 16; ++r) ps += p0[r];
#pragma unroll
    for (int r = 0; r < 16; ++r) ps += p1[r];
    ps = swap_sum(ps);
    l_reg = l_reg * alpha + ps;
    pack_p(p0, p1, pa0, pa1, pa2, pa3);
}
template <int MODE, bool LEAD>
__device__ __forceinline__ void attn_unit_sm_(const bf16_t* Q, int qp, const bf16_t* K, const bf16_t* V, int kvp, bf16_t* O, int op, int pos0, int NT, int koff, const float* logf, ALAS char* lds) {
    static_assert(MODE == 0 || MODE == 2 || MODE == 3, "softmax modes");
    constexpr int ND = (MODE == 0) ? 4 : 8;
    constexpr bool CAUSAL = (MODE != 3);
    constexpr float C2 = 0.08838834764831845f * LOG2E;
    int tid_ = threadIdx.x; asm volatile("" : "+v"(tid_));
    const int tid = tid_, wid = __builtin_amdgcn_readfirstlane(tid >> 6), lane = tid & 63, r32 = lane & 31, hi = lane >> 5;
    const ALAS char* V_lds = lds + OFF_V; const ALAS char* K_lds = lds + OFF_K;
    ALAS float* wsf = (ALAS float*)(lds + OFF_WS) + wid * 64; ALAS float* li_l = wsf; ALAS float* al_l = wsf + 32;
    ALAS float* cum2 = (ALAS float*)(lds + OFF_CUM);
    const int sr = tid >> 4, sc = (tid & 15) * 8, vst0 = v_st(sr, sc), vst1 = v_st(32 + sr, sc), kws = KSWZ(sr, sc * 2);
    const int vb0 = (int)(uintptr_t)(V_lds) + v_rd_base(lane);
    float cq2 = 0.f;
    if constexpr (MODE == 2) {
        const f32x4 v = *(const f32x4*)(logf + 4 * tid);
        const float a0 = v[0], a1 = a0 + v[1], a2 = a1 + v[2], a3 = a2 + v[3];
        float s = a3;
#pragma unroll
        for (int off = 1; off < 64; off <<= 1) { const float t = __shfl_up(s, off); if (lane >= off) s += t; }
        ALAS float* wt = (ALAS float*)(lds + OFF_MISC) + 16;
        if (lane == 63) wt[wid] = s;
        __syncthreads();
        float base = 0.f;
#pragma unroll
        for (int w = 0; w < NW; ++w) { const float t = wt[w]; if (w < wid) base += t; }
        const float ex = s - a3 + base;
        f32x4 c; c[0] = (ex + a0) * LOG2E; c[1] = (ex + a1) * LOG2E; c[2] = (ex + a2) * LOG2E; c[3] = (ex + a3) * LOG2E;
        *(ALAS f32x4*)(cum2 + 4 * tid) = c;
        __syncthreads();
        cq2 = cum2[pos0 + wid * QBLK + r32];
    }
    bf16x8 qr[ND];
#pragma unroll
    for (int d0 = 0; d0 < ND; ++d0) qr[d0] = *(const bf16x8*)(Q + (size_t)(wid * QBLK + r32) * qp + d0 * 16 + hi * 8);
    const int qlo = pos0 + wid * QBLK, qm = qlo + r32 - 4 * hi;
    float m_reg = -1e30f, l_reg = 0.f; f32x16 o[4] = {};
    bf16x8 st_k0, st_k1, st_v0, st_v1;
#define GROW(p, k0, rr) ((p) + (size_t)((k0) + (rr)) * kvp + sc)
#define SLOAD(k0) do { st_v0 = *(const bf16x8*)GROW(V, k0, sr); st_v1 = *(const bf16x8*)GROW(V, k0, 32 + sr); st_k0 = *(const bf16x8*)GROW(K, k0, sr); st_k1 = *(const bf16x8*)GROW(K, k0, 32 + sr); } while (0)
#define SWRITE(bf) do { *(ALAS bf16x8*)(lds + OFF_K + (bf) * SHM_K + kws) = st_k0; *(ALAS bf16x8*)(lds + OFF_K + (bf) * SHM_K + kws + 32 * 256) = st_k1; \
                        *(ALAS bf16x8*)(lds + OFF_V + (bf) * SHM_V + vst0) = st_v0; *(ALAS bf16x8*)(lds + OFF_V + (bf) * SHM_V + vst1) = st_v1; } while (0)
#define RESC(a) do { if (__any((a) < 1.f)) { if (hi == 0) al_l[r32] = (a); asm volatile("s_waitcnt lgkmcnt(0)" ::: "memory"); \
        _Pragma("unroll") for (int d_ = 0; d_ < 4; ++d_) _Pragma("unroll") for (int r = 0; r < 16; ++r) o[d_][r] *= al_l[crow(r, hi)]; } } while (0)
#define PREP(P0_, P1_, t) do { const int kb_ = (t) * KVBLK; \
        if constexpr (MODE == 2) { \
            _Pragma("unroll") for (int g = 0; g < 4; ++g) { const f32x4 c0 = *(const ALAS f32x4*)(cum2 + kb_ + 8 * g + 4 * hi); const f32x4 c1 = *(const ALAS f32x4*)(cum2 + kb_ + 32 + 8 * g + 4 * hi); \
                _Pragma("unroll") for (int k = 0; k < 4; ++k) { P0_[4 * g + k] = fmaf(P0_[4 * g + k], C2, cq2 - c0[k]); P1_[4 * g + k] = fmaf(P1_[4 * g + k], C2, cq2 - c1[k]); } } } \
        if constexpr (CAUSAL) { if (kb_ + KVBLK - 1 > qlo) mask_tile(P0_, P1_, qm - kb_); } } while (0)
    f32x16 pA0, pA1, pB0, pB1; float alA, alB; bf16x8 pa0, pa1, pa2, pa3;
    SLOAD(0); SWRITE(0);
    __syncthreads();
    SLOAD(KVBLK);
    SBAR(); qkt<0, ND>(pA0, pA1, K_lds, r32, hi, qr, koff);
    PREP(pA0, pA1, 0); partialSM<MODE>(pA0, pA1, m_reg, alA);
    SWRITE(1);
    __syncthreads();
#define HALF_STEP(PX0, PX1, alX, PY0, PY1, alY, t, KB, VB, SBUF) do { \
        if ((t) + 1 < NT) { SLOAD(((t) + 1) * KVBLK); } \
          \
        if constexpr (LEAD) { \
            SBAR(); qkt<KB, ND>(PX0, PX1, K_lds, r32, hi, qr, koff); SBAR(); \
            finishSM(PY0, PY1, alY, l_reg, pa0, pa1, pa2, pa3); SBAR(); \
            pv_tile<VB>(o, vb0, pa0, pa1, pa2, pa3); SBAR(); \
            PREP(PX0, PX1, (t)); partialSM<MODE>(PX0, PX1, m_reg, alX); SBAR(); \
        } else { \
            SBAR(); finishSM(PY0, PY1, alY, l_reg, pa0, pa1, pa2, pa3); SBAR(); \
            qkt<KB, ND>(PX0, PX1, K_lds, r32, hi, qr, koff); SBAR(); \
            PREP(PX0, PX1, (t)); partialSM<MODE>(PX0, PX1, m_reg, alX); SBAR(); \
            pv_tile<VB>(o, vb0, pa0, pa1, pa2, pa3); SBAR(); \
        } \
        __syncthreads(); \
        if ((t) + 1 < NT) { SWRITE(SBUF); } \
        RESC(alX); __syncthreads(); if (ATT_XBAR) __syncthreads(); } while (0)
    for (int t = 1; t + 1 < NT; t += 2) {
        HALF_STEP(pB0, pB1, alB, pA0, pA1, alA, t, 1, 0, 0);
        HALF_STEP(pA0, pA1, alA, pB0, pB1, alB, t + 1, 0, 1, 1);
    }
    SBAR(); qkt<1, ND>(pB0, pB1, K_lds, r32, hi, qr, koff); SBAR();
    finishSM(pA0, pA1, alA, l_reg, pa0, pa1, pa2, pa3); SBAR();
    pv_tile<0>(o, vb0, pa0, pa1, pa2, pa3);
    PREP(pB0, pB1, NT - 1); partialSM<MODE>(pB0, pB1, m_reg, alB); RESC(alB);
    finishSM(pB0, pB1, alB, l_reg, pa0, pa1, pa2, pa3); SBAR();
    pv_tile<1>(o, vb0, pa0, pa1, pa2, pa3);
#undef HALF_STEP
#undef PREP
#undef RESC
#undef SWRITE
#undef SLOAD
#undef GROW
    if (hi == 0) li_l[r32] = l_reg; asm volatile("s_waitcnt lgkmcnt(0)" ::: "memory");
    float rli[16];
#pragma unroll
    for (int r = 0; r < 16; ++r) rli[r] = __builtin_amdgcn_rcpf(li_l[crow(r, hi)]);
    store_o(o, rli, O + (size_t)(wid * QBLK) * op, op, lds, wid, lane, r32, hi);
}
template <int MODE>
__device__ __forceinline__ void attn_unit_sm(const bf16_t* Q, int qp, const bf16_t* K, const bf16_t* V, int kvp, bf16_t* O, int op, int pos0, int NT, int koff, const float* logf, ALAS char* lds) {
    const int wid = __builtin_amdgcn_readfirstlane((int)threadIdx.x >> 6);
    if (!ATT_STAGGER || wid < 4) attn_unit_sm_<MODE, true>(Q, qp, K, V, kvp, O, op, pos0, NT, koff, logf, lds);
    else attn_unit_sm_<MODE, false>(Q, qp, K, V, kvp, O, op, pos0, NT, koff, logf, lds);
}
#undef SBAR
#undef KSWZ
}
#define GAS __attribute__((address_space(1)))
#define LAS __attribute__((address_space(3)))
typedef unsigned short bf16;
typedef unsigned v4u __attribute__((ext_vector_type(4)));
typedef float f32x4 __attribute__((ext_vector_type(4)));
typedef short bf16x8 __attribute__((ext_vector_type(8)));
typedef GAS unsigned gu32;
typedef GAS unsigned long long gu64;
#define RLX_AGENT __ATOMIC_RELAXED, __HIP_MEMORY_SCOPE_AGENT
#define LDS_WAIT() asm volatile("s_waitcnt lgkmcnt(0)" ::: "memory")
#define VM_WAIT() asm volatile("s_waitcnt vmcnt(0)" ::: "memory")
__device__ __forceinline__ unsigned long long rt() { return __builtin_amdgcn_s_memrealtime(); }
__device__ __forceinline__ unsigned f2bf(float f) { unsigned u = __builtin_bit_cast(unsigned, f); return (u + 0x7fffu + ((u >> 16) & 1u)) >> 16; }
__device__ __forceinline__ unsigned pk2(float lo, float hi) { return f2bf(lo) | (f2bf(hi) << 16); }

#define XB_TMO      128
#define XB_XCNT(j)  (256  + 64 * (j))
#define XB_XSUB(j)  (1280 + 64 * (j))
#define XB_XGEN(j)  (2304 + 64 * (j))
#define XB_TOP      3328
#define XB_TOPGEN   3392
#define XCD_BAR_WORDS 3456
#define XB_SPIN_CAP (1u << 18)

__device__ __forceinline__ unsigned xb_ld(unsigned* p)              { return __hip_atomic_load(p, __ATOMIC_RELAXED, __HIP_MEMORY_SCOPE_AGENT); }
__device__ __forceinline__ unsigned xb_add(unsigned* p, unsigned v) { return __hip_atomic_fetch_add(p, v, __ATOMIC_RELAXED, __HIP_MEMORY_SCOPE_AGENT); }
__device__ __forceinline__ unsigned xb_xcc_id() { return (unsigned)__builtin_amdgcn_s_getreg((3 << 11) | 20) & 0xFu; }
#define XB_SPIN(cond, bar) do { unsigned _sp = 0; while (cond) { __builtin_amdgcn_s_sleep(1); \
    if ((++_sp & 255u) == 0u) { if (xb_ld(&(bar)[XB_TMO])) break; if (_sp > XB_SPIN_CAP) { atomicAdd(&(bar)[XB_TMO], 1u); break; } } } } while (0)

#ifndef XB_SKIP_WB_ONE_XCC
#define XB_SKIP_WB_ONE_XCC 1
#endif
struct XcdBarrier {
    unsigned* bar; unsigned x;
    volatile LAS unsigned* st;
    unsigned npart;
};

__device__ __forceinline__ XcdBarrier xcd_barrier_post(unsigned* bar, volatile LAS unsigned* st, unsigned npart = 0u) {
    XcdBarrier b; b.bar = bar; b.x = xb_xcc_id(); b.st = st; b.npart = npart;
    if (threadIdx.x == 0) (void)xb_add(&bar[XB_XCNT(b.x)], 1u);
    return b;
}
__device__ __forceinline__ void xcd_barrier_complete(unsigned* bar, unsigned x, unsigned& nloc, unsigned& nx, unsigned npart) {
    const unsigned G = npart ? npart : gridDim.x * gridDim.y * gridDim.z;
    unsigned sum, cnt, mine, sp = 0u;
    for (;;) {
        sum = 0u; cnt = 0u; mine = 0u;
#pragma unroll
        for (unsigned j = 0; j < 16; ++j) { const unsigned c = xb_ld(&bar[XB_XCNT(j)]); sum += c; cnt += (c > 0u) ? 1u : 0u; mine = (j == x) ? c : mine; }
        if (sum == G) break;
        __builtin_amdgcn_s_sleep(1);
        if ((++sp & 255u) == 0u) { if (xb_ld(&bar[XB_TMO])) break; if (sp > XB_SPIN_CAP) { atomicAdd(&bar[XB_TMO], 1u); break; } }
    }
    nloc = mine > 0u ? mine : 1u; nx = cnt > 0u ? cnt : 1u;
}

__device__ __forceinline__ void xcd_barrier(const XcdBarrier& b) {
    asm volatile("s_waitcnt vmcnt(0)" ::: "memory");
    __syncthreads();
    if (threadIdx.x == 0) {
        unsigned* bar = b.bar;
        __builtin_amdgcn_s_waitcnt(0);
        unsigned nloc = b.st[0], nx = b.st[1];
        if (nloc == 0u) { xcd_barrier_complete(bar, b.x, nloc, nx, b.npart); b.st[0] = nloc; b.st[1] = nx; }
        const unsigned old = xb_add(&bar[XB_XSUB(b.x)], 1u);
        const unsigned gen = old / nloc;
        if (old + 1u == (gen + 1u) * nloc) {
            if (!XB_SKIP_WB_ONE_XCC || nx > 1u)
            __builtin_amdgcn_fence(__ATOMIC_RELEASE, "agent");
            asm volatile("s_waitcnt vmcnt(0)" ::: "memory");
            const unsigned og = xb_add(&bar[XB_TOP], 1u);
            const unsigned tg = og / nx;
            if (og + 1u == (tg + 1u) * nx) xb_add(&bar[XB_TOPGEN], 1u);
            else XB_SPIN(xb_ld(&bar[XB_TOPGEN]) == tg, bar);
            __builtin_amdgcn_fence(__ATOMIC_ACQUIRE, "agent");
            xb_add(&bar[XB_XGEN(b.x)], 1u);
            asm volatile("s_waitcnt vmcnt(0)" ::: "memory");
        } else {
            XB_SPIN(xb_ld(&bar[XB_XGEN(b.x)]) == gen, bar);
            __builtin_amdgcn_fence(__ATOMIC_ACQUIRE, "agent");
            asm volatile("s_waitcnt vmcnt(0)" ::: "memory");
        }
    }
    __syncthreads();
}
constexpr int NWAVES = 8;
constexpr int BATCH = 16, SEQ = 2048, DM = 2048, DEPTH = 4, MEMLEN = 256;
constexpr int M = BATCH * SEQ;
constexpr int MM = BATCH * MEMLEN;
constexpr int NPROJ = 6144, INCOLS = 6150, DFF = 5632, CROSSW = 512;
constexpr int QA_C = 0, KA_C = 512, VA_C = 1024, QB_C = 1536, KB_C = 2304, VB_C = 3072, QC_C = 3840, KC_C = 4608, VC_C = 5376;
constexpr float EPS = 1e-6f;
constexpr int N_PHASES = 1 + 12 * DEPTH;
#ifndef PH_MASK
#define PH_MASK 0x1fff
#endif
#define EN(k) (((PH_MASK) >> (k)) & 1)
#ifndef ATTN_PIPE
#define ATTN_PIPE 1
#endif
#if ATTN_PIPE
#define ATTN_SM attn_unit_sm
#else
#define ATTN_SM attn_unit
#endif
#ifndef DUP_A0
#define DUP_A0 1
#endif
#ifndef DUP_A1
#define DUP_A1 1
#endif
#ifndef DUP_A2
#define DUP_A2 1
#endif
#ifndef CLASS_PIPE
#define CLASS_PIPE 1
#endif
#ifndef FFN_SPLIT
#define FFN_SPLIT 1
#endif
#ifndef NT_PROJ
#define NT_PROJ 1
#endif
#ifndef DUP_BAR
#define DUP_BAR 0
#endif
#ifndef DUP_T
#define DUP_T 1
#endif
#ifndef N_BARS
#define N_BARS 1
#endif
#ifndef DUP_A
#define DUP_A 1
#endif
#ifndef DUP_GEMM
#define DUP_GEMM 1
#endif
#ifndef GEMM_SP2
#define GEMM_SP2 true
#endif
#ifndef GEMM_ALIGN
#define GEMM_ALIGN true
#endif
#ifndef EN_A0
#define EN_A0 1
#endif
#ifndef EN_A1
#define EN_A1 1
#endif
#ifndef EN_A2
#define EN_A2 1
#endif
#ifndef EN_G0
#define EN_G0 1
#endif
#ifndef ROPE_TILES
#define ROPE_TILES 4
#endif
#ifndef MK_ONE_LAUNCH
#define MK_ONE_LAUNCH 0
#endif

constexpr size_t MiB = 1u << 20;
constexpr size_t WS_CTL = 0, CTL_ZERO_BYTES = 1 * MiB;
constexpr size_t WS_ROPE = 1 * MiB;
constexpr size_t WS_LOGF = 9 * MiB;
constexpr size_t WS_RS = 9 * MiB + 768 * 1024;
constexpr size_t WS_KV = 10 * MiB;
constexpr size_t WS_W = 42 * MiB, W_LAYER = 102 * MiB;
constexpr size_t WO_IN = 0, WO_OUT = 24 * MiB, WO_CQ = 32 * MiB, WO_CO = 34 * MiB, WO_GU = 36 * MiB, WO_DN = 80 * MiB;
constexpr size_t WS_XB = 450 * MiB;
constexpr size_t WS_YB = 578 * MiB;
constexpr size_t WS_MEMN = WS_YB;
constexpr size_t WS_WCKV = 1090 * MiB;
constexpr size_t OUT_O = 0, OUT_OA = 128 * MiB;
constexpr size_t WS_BIG = 706 * MiB;
constexpr size_t WS_QX = WS_BIG, WS_O2 = WS_BIG + 32 * MiB;
constexpr size_t WS_END = 1106 * MiB;
constexpr int CW_TMO = 0, CW_BAR = 4096, CW_Q = 65536;

constexpr int RING_BYTES = 131072, LDSCTL_OFF = RING_BYTES, MISC_OFF = LDSCTL_OFF + 320, LDS_BYTES = 147456;
static_assert(att::ATT_LDS_BYTES <= RING_BYTES, "attention scratch inside the ring region");

__device__ const double kInvFreq[32] = { 1.0, 0.7498942093324559, 0.5623413251903491, 0.4216965034285822, 0.31622776601683794, 0.23713737056616552, 0.1778279410038923, 0.1333521432163324,
    0.1, 0.07498942093324558, 0.05623413251903491, 0.042169650342858224, 0.03162277660168379, 0.023713737056616554, 0.01778279410038923, 0.01333521432163324,
    0.01, 0.007498942093324558, 0.005623413251903491, 0.004216965034285823, 0.0031622776601683794, 0.0023713737056616554, 0.0017782794100389228, 0.001333521432163324,
    0.001, 0.0007498942093324559, 0.0005623413251903491, 0.00042169650342858224, 0.00031622776601683794, 0.00023713737056616554, 0.00017782794100389227, 0.0001333521432163324 };

struct Args {
    const float* x; const float* mem; const int* pos;
    const float *g_mix_pre, *g_mix_post, *w_in, *b_f, *lam_q1, *lam_k1, *lam_q2, *lam_k2, *g_diff_sub, *g_sb_out, *g_fox_out, *w_out;
    const float *g_x_pre, *g_x_post, *g_mem, *w_cq, *w_ckv, *w_co, *g_ffn_pre, *g_ffn_post, *w_gate, *w_up, *w_down;
    float* out; unsigned char* ws; int ph_lo, ph_hi, li, pad;
};

typedef unsigned u32x2 __attribute__((ext_vector_type(2)));
struct Frame { LAS unsigned char* lds; int tid, lane, wave, vcu, G; int rw0, rwend, rwstride; };
#define PHASE_FENCE(F) do { int t_ = threadIdx.x; asm volatile("" : "+v"(t_)); (F).tid = t_; (F).lane = t_ & 63; } while (0)

__device__ __forceinline__ float wave_sum(float v) {
#pragma unroll
    for (int o = 1; o < 64; o <<= 1) v += __shfl_xor(v, o);
    return v;
}
__device__ __forceinline__ unsigned pkbf(float lo, float hi) { return pg8::cvt_pk_bf16(lo, hi); }
__device__ __forceinline__ float bflo(unsigned w) { return __uint_as_float(w << 16); }
__device__ __forceinline__ float bfhi(unsigned w) { return __uint_as_float(w & 0xffff0000u); }

__device__ __forceinline__ void transpose_item(const float* W, int ld, int K, int k0, int scol, bf16* WT, int n0, LAS float* scr, int lane, const float* gain = nullptr) {
#pragma unroll
    for (int i = 0; i < 32; ++i) { const int kk = 2 * i + (lane >> 5); scr[kk * 33 + (lane & 31)] = W[(size_t)(k0 + kk) * ld + scol]; }
    LDS_WAIT(); asm volatile("" ::: "memory");
    const int c = lane & 7;
    f32x4 ga = {1.f, 1.f, 1.f, 1.f}, gb = {1.f, 1.f, 1.f, 1.f};
    if (gain) { ga = *(const GAS f32x4*)(gain + k0 + 8 * c); gb = *(const GAS f32x4*)(gain + k0 + 8 * c + 4); }
#pragma unroll
    for (int j = 0; j < 4; ++j) { const int n = (lane >> 3) + 8 * j; const LAS float* s = scr + (8 * c) * 33 + n;
        v4u o; o.x = pkbf(s[0 * 33] * ga.x, s[1 * 33] * ga.y); o.y = pkbf(s[2 * 33] * ga.z, s[3 * 33] * ga.w); o.z = pkbf(s[4 * 33] * gb.x, s[5 * 33] * gb.y); o.w = pkbf(s[6 * 33] * gb.z, s[7 * 33] * gb.w);
        *(GAS v4u*)(WT + (size_t)(n0 + n) * K + k0 + 8 * c) = o; }
    LDS_WAIT(); asm volatile("" ::: "memory");
}
__device__ __forceinline__ void p0_weights(Frame& F, const Args& a, unsigned char* ws) {
    LAS float* scr = (LAS float*)(F.lds + F.wave * 16384);
    const int gw = F.vcu * NWAVES + F.wave, NGW = F.G * NWAVES, j = F.lane & 31;
    constexpr int I_IN = 32 * 192, I_OUT = 32 * 64, I_CQ = 32 * 16, I_CKV = 32 * 32, I_CO = 8 * 64, I_GU = 32 * 352, I_DN = 88 * 64;
    constexpr int I_LAYER = I_IN + I_OUT + I_CQ + I_CKV + I_CO + I_GU + I_DN;
    for (int it = gw; it < DEPTH * I_LAYER; it += NGW) {
        const int l = it / I_LAYER; int r = it - l * I_LAYER;
        unsigned char* wl = ws + WS_W + (size_t)l * W_LAYER;
        if (r < I_IN) { const int kb = r / 192, nb = r % 192, n = 32 * nb + j; int sc = n; if (n < 1024) { const int p = n & 63; sc = (n & ~63) + (p >> 1) + 32 * (p & 1); }
            transpose_item(a.w_in + (size_t)l * DM * INCOLS, INCOLS, DM, 64 * kb, sc, (bf16*)(wl + WO_IN), 32 * nb, scr, F.lane, a.g_mix_pre + l * DM); continue; } r -= I_IN;
        if (r < I_OUT) { const int kb = r / 64, nb = r % 64; transpose_item(a.w_out + (size_t)l * DM * DM, DM, DM, 64 * kb, 32 * nb + j, (bf16*)(wl + WO_OUT), 32 * nb, scr, F.lane); continue; } r -= I_OUT;
        if (r < I_CQ) { const int kb = r / 16, nb = r % 16; transpose_item(a.w_cq + (size_t)l * DM * CROSSW, CROSSW, DM, 64 * kb, 32 * nb + j, (bf16*)(wl + WO_CQ), 32 * nb, scr, F.lane, a.g_x_pre + l * DM); continue; } r -= I_CQ;
        if (r < I_CKV) { const int kb = r / 32, nb = r % 32; transpose_item(a.w_ckv + (size_t)l * DM * 1024, 1024, DM, 64 * kb, 32 * nb + j, (bf16*)(ws + WS_WCKV) + (size_t)l * 1024 * DM, 32 * nb, scr, F.lane); continue; } r -= I_CKV;
        if (r < I_CO) { const int kb = r / 64, nb = r % 64; transpose_item(a.w_co + (size_t)l * CROSSW * DM, DM, CROSSW, 64 * kb, 32 * nb + j, (bf16*)(wl + WO_CO), 32 * nb, scr, F.lane); continue; } r -= I_CO;
        if (r < I_GU) { const int kb = r / 352, nb = r % 352, n = 32 * nb + j, pn = n >> 8, rr = n & 255; const float* src = (rr < 128 ? a.w_gate : a.w_up) + (size_t)l * DM * DFF;
            transpose_item(src, DFF, DM, 64 * kb, 128 * pn + (rr & 127), (bf16*)(wl + WO_GU), 32 * nb, scr, F.lane, a.g_ffn_pre + l * DM); continue; } r -= I_GU;
        { const int kb = r / 64, nb = r % 64; transpose_item(a.w_down + (size_t)l * DFF * DM, DM, DFF, 64 * kb, 32 * nb + j, (bf16*)(wl + WO_DN), 32 * nb, scr, F.lane); }
    }
}
__device__ __forceinline__ void p0_rope(Frame& F, const Args& a, unsigned char* ws) {
    float* tab = (float*)(ws + WS_ROPE);
    const int gt = (F.vcu * NWAVES + F.wave) * 64 + F.lane, NT = F.G * NWAVES * 64;
    for (int e = gt; e < M * 32; e += NT) { const int m = e >> 5, i = e & 31;
        const double ang = (double)a.pos[m] * kInvFreq[i]; const double rev = ang * 0.15915494309189535; const double fr = rev - __builtin_floor(rev);
        const float frf = (float)fr;
        tab[(size_t)e * 2] = __builtin_amdgcn_cosf(frf); tab[(size_t)e * 2 + 1] = __builtin_amdgcn_sinf(frf); }
}
__device__ __forceinline__ void p0_memn(Frame& F, const Args& a, unsigned char* ws, int ncl) {
    const int gw = F.vcu * NWAVES + F.wave, NGW = F.G * NWAVES, mpc = MM / ncl;
    for (int t = gw; t < DEPTH * MM; t += NGW) { const int l = t / MM, r = t - l * MM, c = r / mpc, rl = r - c * mpc;
        const GAS f32x4* xr = (const GAS f32x4*)(a.mem + (size_t)r * DM) + F.lane; const GAS f32x4* gr = (const GAS f32x4*)(a.g_mem + (size_t)l * DM) + F.lane;
        f32x4 v[8]; float s = 0.f;
#pragma unroll
        for (int j = 0; j < 8; ++j) { v[j] = xr[64 * j]; s += (v[j].x * v[j].x + v[j].y * v[j].y) + (v[j].z * v[j].z + v[j].w * v[j].w); }
        const float rstd = 1.f / sqrtf(wave_sum(s) * (1.f / DM) + EPS);
        const size_t drow = (size_t)c * (M / ncl) + (size_t)l * mpc + rl;
        GAS unsigned long long* o8 = (GAS unsigned long long*)((bf16*)(ws + WS_MEMN) + drow * DM) + F.lane;
#pragma unroll
        for (int j = 0; j < 8; ++j) { const f32x4 g = gr[64 * j]; o8[64 * j] = (unsigned long long)pkbf(v[j].x * rstd * g.x, v[j].y * rstd * g.y) | ((unsigned long long)pkbf(v[j].z * rstd * g.z, v[j].w * rstd * g.w) << 32); }
    }
}
template <bool FINAL>
__device__ __forceinline__ float row_update(int lane, int m, const bf16* y, const f32x4 (&gp)[8], const float* xin, const bf16* xb, bf16* xbo, float* rs, float* outf, f32x4 (&v)[8]) {
    if (xin) { const GAS f32x4* xr = (const GAS f32x4*)(xin + (size_t)m * DM) + lane;
#pragma unroll
        for (int j = 0; j < 8; ++j) v[j] = xr[64 * j];
    } else { const GAS u32x2* xr = (const GAS u32x2*)(xb + (size_t)m * DM) + lane;
#pragma unroll
        for (int j = 0; j < 8; ++j) { const u32x2 w = xr[64 * j]; v[j] = (f32x4){bflo(w.x), bfhi(w.x), bflo(w.y), bfhi(w.y)}; } }
    if (y) {
        const GAS u32x2* yr = (const GAS u32x2*)(y + (size_t)m * DM) + lane; f32x4 yv[8]; float s = 0.f;
#pragma unroll
        for (int j = 0; j < 8; ++j) { const u32x2 w = yr[64 * j]; yv[j] = (f32x4){bflo(w.x), bfhi(w.x), bflo(w.y), bfhi(w.y)}; s += (yv[j].x * yv[j].x + yv[j].y * yv[j].y) + (yv[j].z * yv[j].z + yv[j].w * yv[j].w); }
        const float rstd = 1.f / sqrtf(wave_sum(s) * (1.f / DM) + EPS);
#pragma unroll
        for (int j = 0; j < 8; ++j) v[j] = v[j] + yv[j] * rstd * gp[j];
    }
    if constexpr (FINAL) {
        GAS f32x4* xo = (GAS f32x4*)(outf + (size_t)m * DM) + lane;
#pragma unroll
        for (int j = 0; j < 8; ++j) xo[64 * j] = v[j];
        return 0.f;
    } else {
        GAS u32x2* o8 = (GAS u32x2*)(xbo + (size_t)m * DM) + lane; float s = 0.f;
#pragma unroll
        for (int j = 0; j < 8; ++j) { o8[64 * j] = (u32x2){pkbf(v[j].x, v[j].y), pkbf(v[j].z, v[j].w)}; s += (v[j].x * v[j].x + v[j].y * v[j].y) + (v[j].z * v[j].z + v[j].w * v[j].w); }
        const float rstd = 1.f / sqrtf(wave_sum(s) * (1.f / DM) + EPS);
        if (lane == 0) rs[m] = rstd;
        return rstd;
    }
}
__device__ __forceinline__ void fc_store(int lane, int m, float t, float rstd, const float* bfv, float* logf) {
    if (lane < 6) {
        const float z = t * rstd + bfv[lane];
        const float ls = fminf(z, 0.f) - log1pf(expf(-fabsf(z)));
        const int b = m / SEQ, s_ = m - b * SEQ; logf[((size_t)b * 6 + lane) * SEQ + s_] = ls; }
}
template <bool FC, bool FINAL>
__device__ __forceinline__ void row_phase(Frame& F, const bf16* y, const float* gpost, const float* xin, const bf16* xb, bf16* xbo, float* rs, float* outf,
                                          const float* wfc_src  , const float* gfc, const float* bfv, float* logf) {
    const int gw = F.rw0, NGW = F.rwstride, MEND = F.rwend;
    LAS float* wfc = (LAS float*)F.lds;
    if constexpr (FC) {
        for (int e = F.tid; e < 6 * DM; e += NWAVES * 64) { const int k = e / 6, jj = e - 6 * k; wfc[jj * DM + k] = wfc_src[(size_t)k * INCOLS + NPROJ + jj] * gfc[k]; }
        __syncthreads();
    }
    f32x4 gp[8];
#pragma unroll
    for (int j = 0; j < 8; ++j) gp[j] = y ? ((const GAS f32x4*)gpost)[F.lane + 64 * j] : (f32x4){0.f, 0.f, 0.f, 0.f};
    if constexpr (FC) {
        for (int m = gw; m < MEND; m += 2 * NGW) {
            const int m1 = m + NGW; f32x4 v0[8], v1[8];
            const float r0 = row_update<false>(F.lane, m, y, gp, xin, xb, xbo, rs, outf, v0);
            const bool two = m1 < MEND; float r1 = 0.f;
#pragma unroll
            for (int j = 0; j < 8; ++j) v1[j] = (f32x4){0.f, 0.f, 0.f, 0.f};
            if (two) r1 = row_update<false>(F.lane, m1, y, gp, xin, xb, xbo, rs, outf, v1);
            float ta = 0.f, tb = 0.f;
#pragma unroll
            for (int jj = 0; jj < 6; ++jj) { float a0 = 0.f, a1 = 0.f;
#pragma unroll
                for (int j = 0; j < 8; ++j) { const f32x4 w = *(const LAS f32x4*)(wfc + jj * DM + 4 * F.lane + 256 * j);
                    a0 += (v0[j].x * w.x + v0[j].y * w.y) + (v0[j].z * w.z + v0[j].w * w.w); a1 += (v1[j].x * w.x + v1[j].y * w.y) + (v1[j].z * w.z + v1[j].w * w.w); }
                const float sa = wave_sum(a0), sb = wave_sum(a1); ta = (F.lane == jj) ? sa : ta; tb = (F.lane == jj) ? sb : tb; }
            fc_store(F.lane, m, ta, r0, bfv, logf);
            if (two) fc_store(F.lane, m1, tb, r1, bfv, logf);
        }
        __syncthreads();
    } else {
        for (int m = gw; m < MEND; m += NGW) { f32x4 v[8]; (void)row_update<FINAL>(F.lane, m, y, gp, xin, xb, xbo, rs, outf, v); }
    }
}
__device__ __forceinline__ void subnorm_phase(Frame& F, const Args& a, int l, const bf16* OA, bf16* HB) {
    const int gw = F.rw0, NGW = F.rwstride, MEND = F.rwend, lane = F.lane;
    const float d1 = wave_sum(a.lam_q1[l * 64 + lane] * a.lam_k1[l * 64 + lane]), d2 = wave_sum(a.lam_q2[l * 64 + lane] * a.lam_k2[l * 64 + lane]);
    const float lam_init = 0.8f - 0.6f * expf(-0.3f * (float)l);
    const float lam = (expf(d1) - expf(d2)) + lam_init, post = 1.0f - lam_init;
    const int hd = lane >> 4, c8 = (lane & 15) * 8;
    f32x4 gd0 = *(const GAS f32x4*)(a.g_diff_sub + l * 128 + c8), gd1 = *(const GAS f32x4*)(a.g_diff_sub + l * 128 + c8 + 4);
    f32x4 gs[3], gf[3];
#pragma unroll
    for (int j = 0; j < 3; ++j) { gs[j] = *(const GAS f32x4*)(a.g_sb_out + l * 768 + 4 * lane + 256 * j); gf[j] = *(const GAS f32x4*)(a.g_fox_out + l * 768 + 4 * lane + 256 * j); }
    for (int m = gw; m < MEND; m += NGW) {
        const v4u w1 = *(const GAS v4u*)(OA + (size_t)m * 1024 + hd * 256 + c8), w2 = *(const GAS v4u*)(OA + (size_t)m * 1024 + hd * 256 + 128 + c8);
        bf16* hr = HB + (size_t)m * DM;
        u32x2 sb[3], fx[3];
#pragma unroll
        for (int j = 0; j < 3; ++j) { sb[j] = *(const GAS u32x2*)(hr + 512 + 4 * lane + 256 * j); fx[j] = *(const GAS u32x2*)(hr + 1280 + 4 * lane + 256 * j); }
        float d[8];
        d[0] = bflo(w1.x) - lam * bflo(w2.x); d[1] = bfhi(w1.x) - lam * bfhi(w2.x); d[2] = bflo(w1.y) - lam * bflo(w2.y); d[3] = bfhi(w1.y) - lam * bfhi(w2.y);
        d[4] = bflo(w1.z) - lam * bflo(w2.z); d[5] = bfhi(w1.z) - lam * bfhi(w2.z); d[6] = bflo(w1.w) - lam * bflo(w2.w); d[7] = bfhi(w1.w) - lam * bfhi(w2.w);
        float s = 0.f;
#pragma unroll
        for (int k = 0; k < 8; ++k) s += d[k] * d[k];
        s += __shfl_xor(s, 1); s += __shfl_xor(s, 2); s += __shfl_xor(s, 4); s += __shfl_xor(s, 8);
        const float rd = post / sqrtf(s * (1.f / 128.f) + EPS);
        v4u od; od.x = pkbf(d[0] * rd * gd0.x, d[1] * rd * gd0.y); od.y = pkbf(d[2] * rd * gd0.z, d[3] * rd * gd0.w); od.z = pkbf(d[4] * rd * gd1.x, d[5] * rd * gd1.y); od.w = pkbf(d[6] * rd * gd1.z, d[7] * rd * gd1.w);
        *(GAS v4u*)(hr + hd * 128 + c8) = od;
        float ss = 0.f, sf = 0.f; f32x4 vs[3], vf[3];
#pragma unroll
        for (int j = 0; j < 3; ++j) { vs[j] = (f32x4){bflo(sb[j].x), bfhi(sb[j].x), bflo(sb[j].y), bfhi(sb[j].y)}; vf[j] = (f32x4){bflo(fx[j].x), bfhi(fx[j].x), bflo(fx[j].y), bfhi(fx[j].y)};
            ss += (vs[j].x * vs[j].x + vs[j].y * vs[j].y) + (vs[j].z * vs[j].z + vs[j].w * vs[j].w); sf += (vf[j].x * vf[j].x + vf[j].y * vf[j].y) + (vf[j].z * vf[j].z + vf[j].w * vf[j].w); }
        const float rs = 1.f / sqrtf(wave_sum(ss) * (1.f / 768.f) + EPS), rf = 1.f / sqrtf(wave_sum(sf) * (1.f / 768.f) + EPS);
#pragma unroll
        for (int j = 0; j < 3; ++j) { const f32x4 u = vs[j] * rs * gs[j], w = vf[j] * rf * gf[j];
            *(GAS u32x2*)(hr + 512 + 4 * lane + 256 * j) = (u32x2){pkbf(u.x, u.y), pkbf(u.z, u.w)}; *(GAS u32x2*)(hr + 1280 + 4 * lane + 256 * j) = (u32x2){pkbf(w.x, w.y), pkbf(w.z, w.w)}; }
    }
}
__device__ __forceinline__ unsigned claim_issue(Frame& F, gu32* ctr) {
    unsigned v = 0u;
    if (F.tid == 0) v = __hip_atomic_fetch_add(ctr, 1u, __ATOMIC_RELAXED, __HIP_MEMORY_SCOPE_AGENT);
    return v;
}
__device__ __forceinline__ int claim_publish(Frame& F, unsigned v) {
    LAS unsigned* slot = (LAS unsigned*)(F.lds + att::OFF_MISC);
    if (F.tid == 0) *slot = v;
    __syncthreads();
    const int r = (int)*slot;
    __syncthreads();
    return r;
}
__global__ void __launch_bounds__(NWAVES * 64, 2) trunk_fwd(Args args) {
    extern __shared__ __attribute__((aligned(16))) unsigned char lds[];
    Frame F;
    F.lds = (LAS unsigned char*)lds;
    F.tid = threadIdx.x; F.lane = F.tid & 63; F.wave = __builtin_amdgcn_readfirstlane(F.tid >> 6);
    F.G = gridDim.x; { const int bx = blockIdx.x; F.vcu = (F.G % 8 == 0) ? (bx % 8) * (F.G / 8) + bx / 8 : bx; }
    unsigned char* ws = args.ws;
    gu32* ctl = (gu32*)(ws + WS_CTL);
    volatile LAS unsigned* MISC = (volatile LAS unsigned*)(F.lds + MISC_OFF);
    for (int u = F.tid; u < (LDS_BYTES - LDSCTL_OFF) / 4; u += NWAVES * 64) ((LAS unsigned*)(F.lds + LDSCTL_OFF))[u] = 0u;
    __syncthreads();
    const int ncl = (CLASS_PIPE && F.G % 8 == 0) ? 8 : 1, xc = (ncl == 8) ? ((int)blockIdx.x & 7) : 0, rk = (ncl == 8) ? ((int)blockIdx.x >> 3) : (int)blockIdx.x, NC = F.G / ncl;
    const int crows = M / ncl, crow0 = xc * crows, bpc = BATCH / ncl, mpc = MM / ncl;
    XcdBarrier bar; bar.bar = (unsigned*)(ctl + CW_BAR); bar.x = 0; bar.st = nullptr; bar.npart = 0u;
    XcdBarrier cbar = bar;
    const int lo = args.ph_lo, hi = args.ph_hi;
    if (hi - lo > 1) { bar = xcd_barrier_post((unsigned*)(ctl + CW_BAR), MISC + 8);
        cbar = (ncl == 8) ? xcd_barrier_post((unsigned*)(ctl + CW_BAR) + (1 + xc) * XCD_BAR_WORDS, MISC + 10, (unsigned)NC) : bar; }
#define SET_ROWS_GLOBAL() do { F.rw0 = F.vcu * NWAVES + F.wave; F.rwend = M; F.rwstride = F.G * NWAVES; } while (0)
#define SET_ROWS_CLASS()  do { F.rw0 = crow0 + rk * NWAVES + F.wave; F.rwend = crow0 + crows; F.rwstride = NC * NWAVES; } while (0)
#define CLASS_BAR() xcd_barrier(cbar)
#define GRID_BAR() xcd_barrier(bar)
#define IN(k) (lo <= (k) && (k) < hi)
#define BOTH(k) (IN(k) && IN((k) + 1))
#define ALDS ((__attribute__((address_space(3))) char*)F.lds)
    bf16* XB = (bf16*)(ws + WS_XB); bf16* YB = (bf16*)(ws + WS_YB); bf16* PROJ = (bf16*)(ws + WS_BIG); float* RS = (float*)(ws + WS_RS);
    float* LOGF = (float*)(ws + WS_LOGF); const float* ROPE = (const float*)(ws + WS_ROPE);
    bf16* XBc = XB + (size_t)crow0 * DM; bf16* YBc = YB + (size_t)crow0 * DM; bf16* PROJc = PROJ + (size_t)crow0 * NPROJ; float* RSc = RS + crow0; const float* ROPEc = ROPE + (size_t)crow0 * 64;
    bf16* BIGc = PROJc;
    bf16* HIDc = BIGc; bf16* QXc = BIGc; bf16* O2c = BIGc + (size_t)crows * CROSSW;
    bf16* QXv = QXc - (size_t)crow0 * CROSSW; bf16* O2v = O2c - (size_t)crow0 * CROSSW;
    bf16* HBc = (bf16*)((unsigned char*)args.out + (size_t)crow0 * DM * 4); bf16* OAc = HBc + (size_t)crows * DM;
    bf16* HBv = HBc - (size_t)crow0 * DM; bf16* OAv = OAc - (size_t)crow0 * 1024;
    const bf16* MEMNc = (const bf16*)(ws + WS_MEMN) + (size_t)crow0 * DM;
    bf16* KVc = (bf16*)(ws + WS_KV) + (size_t)xc * DEPTH * mpc * 1024;

    if (EN(0) && IN(0)) { PHASE_FENCE(F);
        p0_weights(F, args, ws);
        p0_rope(F, args, ws);
        p0_memn(F, args, ws, ncl);
        __syncthreads();
        SET_ROWS_GLOBAL();
        row_phase<true, false>(F, nullptr, nullptr, args.x, XB, XB, RS, nullptr, args.w_in, args.g_mix_pre, args.b_f, LOGF);
        if (BOTH(0)) GRID_BAR();
    }
    SET_ROWS_CLASS();
#if defined(DEPHASE_US)
    if (hi - lo > 1) { if (F.tid == 0) { const unsigned long long t0 = __builtin_amdgcn_s_memrealtime(); while (__builtin_amdgcn_s_memrealtime() - t0 < (unsigned long long)(xc * DEPHASE_US * 100)) __builtin_amdgcn_s_sleep(8); } __syncthreads(); }
#endif
    for (int l = 0; l < DEPTH; ++l) {
        const int pb = 1 + 12 * l;
        unsigned char* wl = ws + WS_W + (size_t)l * W_LAYER;
        if (EN(1) && IN(pb + 0)) { PHASE_FENCE(F);
            if (EN_G0 && l == 0) { pg8::Gemm g{MEMNc, (const bf16*)(ws + WS_WCKV), DEPTH * mpc, DEPTH * 1024, DM}; pg8::KvOrder S{mpc / 256, NC, rk};
                pg8::EpiStore E{KVc, 1024, nullptr, 0, 3, nullptr}; pg8::gemm_phase<pg8::EpiStore, pg8::KvOrder, GEMM_ALIGN, GEMM_SP2>(F.lds, g, S, E); }
            pg8::Gemm g{XBc, (const bf16*)(wl + WO_IN), crows, NPROJ, DM}; pg8::ClassOrder S; S.init(crows, NPROJ, NC, rk);
            pg8::EpiStore E{PROJc, NPROJ, ROPEc, ROPE_TILES, -1, RSc}; pg8::gemm_phase<pg8::EpiStore, pg8::ClassOrder, GEMM_ALIGN, GEMM_SP2>(F.lds, g, S, E);
            if (BOTH(pb + 0)) CLASS_BAR();
        }
        if (EN(2) && IN(pb + 1)) { PHASE_FENCE(F);
            const int nbh = bpc * 6, nbv = bpc * 8;
            gu32* q0 = ctl + CW_Q + 64 * ((3 * l) * 8 + xc);
            { gu32* qc_ = q0; unsigned pend_ = claim_issue(F, qc_); for (int u = claim_publish(F, pend_); u < 8 * nbh; u = claim_publish(F, pend_)) { pend_ = claim_issue(F, qc_); const int qb = 7 - u / nbh, bh = xc * nbh + u % nbh, b = bh / 6, h = bh % 6;
                const size_t r0 = (size_t)b * SEQ; const int pos0 = qb * 256;
                att::attn_unit<1>(PROJ + (r0 + pos0) * NPROJ + QB_C + h * 128, NPROJ, PROJ + r0 * NPROJ + KB_C + h * 128, PROJ + r0 * NPROJ + VB_C + h * 128, NPROJ,
                                  HBv + (r0 + pos0) * DM + 512 + h * 128, DM, pos0, 4 * (qb + 1), 0, nullptr, ALDS); } }
            { gu32* qc_ = q0 + 64 * 8; unsigned pend_ = claim_issue(F, qc_); for (int u = claim_publish(F, pend_); u < 8 * nbh; u = claim_publish(F, pend_)) { pend_ = claim_issue(F, qc_); const int qb = 7 - u / nbh, bh = xc * nbh + u % nbh, b = bh / 6, h = bh % 6;
                const size_t r0 = (size_t)b * SEQ; const int pos0 = qb * 256;
                att::ATTN_SM<2>(PROJ + (r0 + pos0) * NPROJ + QC_C + h * 128, NPROJ, PROJ + r0 * NPROJ + KC_C + h * 128, PROJ + r0 * NPROJ + VC_C + h * 128, NPROJ,
                                  HBv + (r0 + pos0) * DM + 1280 + h * 128, DM, pos0, 4 * (qb + 1), 0, LOGF + (size_t)bh * SEQ, ALDS); } }
            { gu32* qc_ = q0 + 64 * 16; unsigned pend_ = claim_issue(F, qc_); for (int u = claim_publish(F, pend_); u < 8 * nbv; u = claim_publish(F, pend_)) { pend_ = claim_issue(F, qc_); const int qb = 7 - u / nbv, bv = xc * nbv + u % nbv, b = bv / 8, vh = bv % 8, h = vh >> 1, jm = vh & 1;
                const size_t r0 = (size_t)b * SEQ; const int pos0 = qb * 256;
                att::ATTN_SM<0>(PROJ + (r0 + pos0) * NPROJ + QA_C + h * 128 + jm * 64, NPROJ, PROJ + r0 * NPROJ + KA_C + h * 128, PROJ + r0 * NPROJ + VA_C + h * 128, NPROJ,
                                  OAv + (r0 + pos0) * 1024 + vh * 128, 1024, pos0, 4 * (qb + 1), jm * 128, nullptr, ALDS); } }
            if (BOTH(pb + 1)) CLASS_BAR();
        }
        if (EN(3) && IN(pb + 2)) { PHASE_FENCE(F); subnorm_phase(F, args, l, OAv, HBv); if (BOTH(pb + 2)) CLASS_BAR(); }
        if (EN(4) && IN(pb + 3)) { PHASE_FENCE(F);
            pg8::Gemm g{HBc, (const bf16*)(wl + WO_OUT), crows, DM, DM}; pg8::ClassOrder S; S.init(crows, DM, NC, rk);
            pg8::EpiStore E{YBc, DM, nullptr, 0, -1, nullptr}; pg8::gemm_phase<pg8::EpiStore, pg8::ClassOrder, GEMM_ALIGN, GEMM_SP2>(F.lds, g, S, E);
            if (BOTH(pb + 3)) CLASS_BAR();
        }
        if (EN(5) && IN(pb + 4)) { PHASE_FENCE(F);
            row_phase<false, false>(F, YB, args.g_mix_post + l * DM, nullptr, XB, XB, RS, nullptr, nullptr, nullptr, nullptr, nullptr); if (BOTH(pb + 4)) CLASS_BAR(); }
        if (EN(6) && IN(pb + 5)) { PHASE_FENCE(F);
            pg8::Gemm g{XBc, (const bf16*)(wl + WO_CQ), crows, CROSSW, DM}; pg8::ClassOrder S; S.init(crows, CROSSW, NC, rk);
            pg8::EpiStore E{QXc, CROSSW, nullptr, 0, -1, RSc}; pg8::gemm_phase<pg8::EpiStore, pg8::ClassOrder, GEMM_ALIGN, GEMM_SP2>(F.lds, g, S, E);
            if (BOTH(pb + 5)) CLASS_BAR();
        }
        if (EN(7) && IN(pb + 6)) { PHASE_FENCE(F);
            const bf16* kvl = KVc + (size_t)l * mpc * 1024;
            for (int u = rk; u < bpc * 4 * 8; u += NC) { const int qb = u & 7, bh = u >> 3, lb = bh >> 2, h = bh & 3; const size_t r0 = (size_t)(xc * bpc + lb) * SEQ + qb * 256;
                att::ATTN_SM<3>(QXv + r0 * CROSSW + h * 128, CROSSW, kvl + (size_t)lb * MEMLEN * 1024 + h * 128, kvl + (size_t)lb * MEMLEN * 1024 + 512 + h * 128, 1024,
                                  O2v + r0 * CROSSW + h * 128, CROSSW, 0, 4, 0, nullptr, ALDS); }
            if (BOTH(pb + 6)) CLASS_BAR();
        }
        if (EN(8) && IN(pb + 7)) { PHASE_FENCE(F);
            pg8::Gemm g{O2c, (const bf16*)(wl + WO_CO), crows, DM, CROSSW}; pg8::ClassOrder S; S.init(crows, DM, NC, rk);
            pg8::EpiStore E{YBc, DM, nullptr, 0, -1, nullptr}; pg8::gemm_phase<pg8::EpiStore, pg8::ClassOrder, GEMM_ALIGN, GEMM_SP2>(F.lds, g, S, E);
            if (BOTH(pb + 7)) CLASS_BAR();
        }
        if (EN(9) && IN(pb + 8)) { PHASE_FENCE(F);
            row_phase<false, false>(F, YB, args.g_x_post + l * DM, nullptr, XB, XB, RS, nullptr, nullptr, nullptr, nullptr, nullptr); if (BOTH(pb + 8)) CLASS_BAR(); }
        if (EN(10) && IN(pb + 9)) { PHASE_FENCE(F);
            pg8::Gemm g{XBc, (const bf16*)(wl + WO_GU), crows, 2 * DFF, DM}; pg8::ClassOrder S; S.init(crows, 2 * DFF, NC, rk);
            pg8::EpiSwiGLU E{HIDc, DFF, RSc}; pg8::gemm_phase<pg8::EpiSwiGLU, pg8::ClassOrder, GEMM_ALIGN, GEMM_SP2>(F.lds, g, S, E);
            if (BOTH(pb + 9)) CLASS_BAR();
        }
        if (EN(11) && IN(pb + 10)) { PHASE_FENCE(F);
            pg8::Gemm g{HIDc, (const bf16*)(wl + WO_DN), crows, DM, DFF}; pg8::ClassOrder S; S.init(crows, DM, NC, rk);
            pg8::EpiStore E{YBc, DM, nullptr, 0, -1, nullptr}; pg8::gemm_phase<pg8::EpiStore, pg8::ClassOrder, GEMM_ALIGN, GEMM_SP2>(F.lds, g, S, E);
            if (BOTH(pb + 10)) CLASS_BAR();
        }
        if (EN(12) && IN(pb + 11)) { PHASE_FENCE(F);
            if (l + 1 < DEPTH) row_phase<true, false>(F, YB, args.g_ffn_post + l * DM, nullptr, XB, XB, RS, nullptr, args.w_in + (size_t)(l + 1) * DM * INCOLS, args.g_mix_pre + (l + 1) * DM, args.b_f + (l + 1) * 6, LOGF);
            else row_phase<false, true>(F, YB, args.g_ffn_post + l * DM, nullptr, XB, XB, nullptr, args.out, nullptr, nullptr, nullptr, nullptr);
            if (BOTH(pb + 11)) CLASS_BAR();
        }
    }
#undef IN
#undef BOTH
#undef GRID_BAR
#undef CLASS_BAR
#undef SET_ROWS_GLOBAL
#undef SET_ROWS_CLASS
#undef ALDS
}

extern "C" void kernel_launch(void* const* d_in, const int* in_sizes, int n_in, void* d_out, int out_size, void* d_ws, size_t ws_size, hipStream_t stream) {
    static int grid = 0;
    if (grid == 0) {
        if (n_in != 26 || in_sizes[0] != M * DM || out_size != M * DM || ws_size < WS_END) { fprintf(stderr, "kernel_launch: unexpected shapes (n_in %d, in0 %d, out %d, ws %zu)\n", n_in, n_in > 0 ? in_sizes[0] : -1, out_size, ws_size); grid = -1; return; }
        int dev = 0, cus = 0, per_cu = 0;
        if (hipGetDevice(&dev) != hipSuccess || hipDeviceGetAttribute(&cus, hipDeviceAttributeMultiprocessorCount, dev) != hipSuccess) { grid = -1; return; }
        if (hipFuncSetAttribute((const void*)trunk_fwd, hipFuncAttributeMaxDynamicSharedMemorySize, LDS_BYTES) != hipSuccess) { fprintf(stderr, "kernel_launch: hipFuncSetAttribute failed\n"); grid = -1; return; }
        if (hipOccupancyMaxActiveBlocksPerMultiprocessor(&per_cu, (const void*)trunk_fwd, NWAVES * 64, LDS_BYTES) != hipSuccess || per_cu < 1) fprintf(stderr, "kernel_launch: occupancy query reports %d\n", per_cu);
        (void)hipGetLastError();
        grid = cus;
    }
    if (grid < 0) return;
    if (hipMemsetAsync((char*)d_ws + WS_CTL, 0, CTL_ZERO_BYTES, stream) != hipSuccess) return;
    Args a{};
    a.x = (const float*)d_in[0]; a.mem = (const float*)d_in[1]; a.pos = (const int*)d_in[2];
    a.g_mix_pre = (const float*)d_in[3]; a.g_mix_post = (const float*)d_in[4]; a.w_in = (const float*)d_in[5]; a.b_f = (const float*)d_in[6];
    a.lam_q1 = (const float*)d_in[7]; a.lam_k1 = (const float*)d_in[8]; a.lam_q2 = (const float*)d_in[9]; a.lam_k2 = (const float*)d_in[10];
    a.g_diff_sub = (const float*)d_in[11]; a.g_sb_out = (const float*)d_in[12]; a.g_fox_out = (const float*)d_in[13]; a.w_out = (const float*)d_in[14];
    a.g_x_pre = (const float*)d_in[15]; a.g_x_post = (const float*)d_in[16]; a.g_mem = (const float*)d_in[17]; a.w_cq = (const float*)d_in[18]; a.w_ckv = (const float*)d_in[19]; a.w_co = (const float*)d_in[20];
    a.g_ffn_pre = (const float*)d_in[21]; a.g_ffn_post = (const float*)d_in[22]; a.w_gate = (const float*)d_in[23]; a.w_up = (const float*)d_in[24]; a.w_down = (const float*)d_in[25];
    a.out = (float*)d_out; a.ws = (unsigned char*)d_ws;
#if MK_ONE_LAUNCH
#if defined(PROBE_PRE_HI)
    a.ph_lo = 0; a.ph_hi = PROBE_PRE_HI; a.li = 1;
    hipLaunchKernelGGL(trunk_fwd, dim3(grid), dim3(NWAVES * 64), LDS_BYTES, stream, a); (void)hipMemsetAsync((char*)d_ws + WS_CTL, 0, CTL_ZERO_BYTES, stream);
#endif
    a.ph_lo = 0; a.ph_hi = N_PHASES; a.li = 0;
    hipLaunchKernelGGL(trunk_fwd, dim3(grid), dim3(NWAVES * 64), LDS_BYTES, stream, a);
#if defined(PROBE_POST_HI)
    (void)hipMemsetAsync((char*)d_ws + WS_CTL, 0, CTL_ZERO_BYTES, stream); a.ph_lo = 0; a.ph_hi = PROBE_POST_HI; a.li = 1;
    hipLaunchKernelGGL(trunk_fwd, dim3(grid), dim3(NWAVES * 64), LDS_BYTES, stream, a);
#endif
#if defined(PROBE_PRE_HI)
#endif
#else
    for (int p = 0; p < N_PHASES; ++p) { a.ph_lo = p; a.ph_hi = p + 1; a.li = p;
        hipLaunchKernelGGL(trunk_fwd, dim3(grid), dim3(NWAVES * 64), LDS_BYTES, stream, a); }
#endif
}
```

```cpp
#include <hip/hip_runtime.h>
#include <hip/hip_bf16.h>
#include <cstdio>
#include <cstdint>
#include <cmath>
#define MK_ONE_LAUNCH 1
namespace pg8 {
#define PG8_LAS __attribute__((address_space(3)))
typedef unsigned short bf16_t;
typedef short bf16x8 __attribute__((ext_vector_type(8)));
typedef float f32x4 __attribute__((ext_vector_type(4)));
typedef unsigned u32x4 __attribute__((ext_vector_type(4)));
constexpr int BM = 256, BK = 64, HALF = 128, HTB = HALF * BK * 2  , STAGE_BYTES = 8 * HTB, NXCD = 8, WGM = 8;

__host__ __device__ __forceinline__ int lds_byte(int r, int c) { const int st = (r >> 4) * 2 + (c >> 5), rr = r & 15, cc = c & 31, ob = rr * 64 + cc * 2; return st * 1024 + (ob ^ (((ob >> 9) & 1) << 5)); }
__host__ __device__ __forceinline__ void stage_rc(int b, int& R, int& C) { const int st = b / 1024, sb = b % 1024, swz = sb ^ (((sb >> 9) & 1) << 5); R = (st >> 1) * 16 + swz / 64; C = (st & 1) * 32 + (swz % 64) / 2; }
__host__ __device__ __forceinline__ int perm32(int rho) { const int n = rho >> 4, i = rho & 15; return 8 * (i >> 2) + 4 * n + (i & 3); }

struct Unit { int pm, pn; };
struct Gemm { const bf16_t* A; const bf16_t* Bt; int M, N, K; };

struct StaticOrder {
    int nM, nN, nwg, G, c;
    __host__ __device__ void init(int M, int N, int G_, int c_) { nM = M / BM; nN = N / BM; nwg = nM * nN; G = G_; c = c_; }
    __host__ __device__ bool next(int i, Unit& u) const {
        const long L = (long)i * G + c; if (L >= nwg) return false;
        int wgid = (int)L; { const int q = nwg / NXCD, r = nwg % NXCD, xcd = wgid % NXCD, off = wgid / NXCD; wgid = (xcd < r ? xcd * (q + 1) : r * (q + 1) + (xcd - r) * q) + off; }
        const int nig = WGM * nN, gid = wgid / nig, fm = gid * WGM, gsz = (nM - fm) < WGM ? (nM - fm) : WGM;
        u.pm = fm + ((wgid % nig) % gsz); u.pn = (wgid % nig) / gsz; return true;
    }
    __device__ __forceinline__ void a_ready(const Unit&) const {}
    __device__ __forceinline__ void done(const Unit&) const {}
};

__device__ __forceinline__ unsigned cvt_pk_bf16(float lo, float hi) { unsigned r; asm volatile("v_cvt_pk_bf16_f32 %0, %1, %2" : "=v"(r) : "v"(lo), "v"(hi)); return r; }
typedef float f32x2 __attribute__((ext_vector_type(2)));
struct EpiStore {
    static constexpr bool PERM = true, AFTER_DRAIN = false;
    bf16_t* O; int ldc; const float* rope; int rope_tiles; int pn_mask;
    const float* rs;
    __device__ __forceinline__ void prefetch(const Unit& u, int wr, int fr, float (&epre)[8]) const {
        const int row0 = u.pm * BM + wr * 64 + fr;
#pragma unroll
        for (int i = 0; i < 8; ++i) epre[i] = rs ? rs[row0 + (i >> 2) * HALF + (i & 3) * 16] : 1.0f;
    }
    __device__ __forceinline__ void operator()(const f32x4 (&acc)[2][2][4][2], const Unit& u, int wr, int wc, int fr, int fq, const float (&epre)[8]) const {
        const int row0 = u.pm * BM + wr * 64 + fr; const int col0 = (u.pn & pn_mask) * BM + wc * 32 + 8 * fq;
        const bool do_rope = u.pn < rope_tiles;
#pragma unroll
        for (int ai = 0; ai < 2; ++ai)
#pragma unroll
            for (int m = 0; m < 4; ++m) { const int row = row0 + ai * HALF + m * 16; bf16_t* rowp = O + (size_t)row * ldc + col0;
                f32x4 cs0 = {1.f, 0.f, 1.f, 0.f}, cs1 = {1.f, 0.f, 1.f, 0.f}; const float rsc = epre[ai * 4 + m];
                if (do_rope) { const float* rp = rope + (size_t)row * 64 + (16 * (wc & 1) + 4 * fq) * 2; cs0 = *(const f32x4*)rp; cs1 = *(const f32x4*)(rp + 4); }
#pragma unroll
                for (int bj = 0; bj < 2; ++bj) { f32x4 v0 = acc[ai][bj][m][0] * rsc, v1 = acc[ai][bj][m][1] * rsc;
                    if (do_rope) {
                        f32x4 r0, r1;
                        r0[0] = v0[0] * cs0[0] - v0[1] * cs0[1]; r0[1] = v0[1] * cs0[0] + v0[0] * cs0[1];
                        r0[2] = v0[2] * cs0[2] - v0[3] * cs0[3]; r0[3] = v0[3] * cs0[2] + v0[2] * cs0[3];
                        r1[0] = v1[0] * cs1[0] - v1[1] * cs1[1]; r1[1] = v1[1] * cs1[0] + v1[0] * cs1[1];
                        r1[2] = v1[2] * cs1[2] - v1[3] * cs1[3]; r1[3] = v1[3] * cs1[2] + v1[2] * cs1[3];
                        v0 = r0; v1 = r1; }
                    u32x4 w; w.x = cvt_pk_bf16(v0[0], v0[1]); w.y = cvt_pk_bf16(v0[2], v0[3]); w.z = cvt_pk_bf16(v1[0], v1[1]); w.w = cvt_pk_bf16(v1[2], v1[3]);
                    *(u32x4*)(rowp + bj * HALF) = w; } }
    }
};
struct EpiSwiGLU {
    static constexpr bool PERM = true, AFTER_DRAIN = false;
    bf16_t* O; int ldc; const float* rs;
    __device__ __forceinline__ static float sw(float g, float up) { const float e = __builtin_amdgcn_exp2f(-1.4426950408889634f * g); return g * up * __builtin_amdgcn_rcpf(1.0f + e); }
    __device__ __forceinline__ void prefetch(const Unit& u, int wr, int fr, float (&epre)[8]) const {
        const int row0 = u.pm * BM + wr * 64 + fr;
#pragma unroll
        for (int i = 0; i < 8; ++i) epre[i] = rs[row0 + (i >> 2) * HALF + (i & 3) * 16];
    }
    __device__ __forceinline__ void operator()(const f32x4 (&acc)[2][2][4][2], const Unit& u, int wr, int wc, int fr, int fq, const float (&epre)[8]) const {
        const int row0 = u.pm * BM + wr * 64 + fr; const int col0 = u.pn * HALF + wc * 32 + 8 * fq;
#pragma unroll
        for (int ai = 0; ai < 2; ++ai)
#pragma unroll
            for (int m = 0; m < 4; ++m) { const int row = row0 + ai * HALF + m * 16; bf16_t* rowp = O + (size_t)row * ldc + col0;
                const float rsc = epre[ai * 4 + m];
                const f32x4 g0 = acc[ai][0][m][0] * rsc, g1 = acc[ai][0][m][1] * rsc, u0 = acc[ai][1][m][0] * rsc, u1 = acc[ai][1][m][1] * rsc;
                u32x4 w; w.x = cvt_pk_bf16(sw(g0[0], u0[0]), sw(g0[1], u0[1])); w.y = cvt_pk_bf16(sw(g0[2], u0[2]), sw(g0[3], u0[3]));
                w.z = cvt_pk_bf16(sw(g1[0], u1[0]), sw(g1[1], u1[1])); w.w = cvt_pk_bf16(sw(g1[2], u1[2]), sw(g1[3], u1[3]));
                *(u32x4*)rowp = w; }
    }
};
struct ClassOrder {
    int nM, nN, NC, rk;
    __host__ __device__ void init(int M, int N, int NC_, int rk_) { nM = M / BM; nN = N / BM; NC = NC_; rk = rk_; }
    __host__ __device__ bool next(int i, Unit& u) const { const int L = i * NC + rk; if (L >= nM * nN) return false;
        const int per = 8 * nN, g = L / per, r = L - g * per, gs = (nM - 8 * g) < 8 ? (nM - 8 * g) : 8; u.pm = 8 * g + r % gs; u.pn = r / gs; return true; }
    __device__ __forceinline__ void a_ready(const Unit&) const {}
    __device__ __forceinline__ void done(const Unit&) const {}
};
struct KvOrder {
    int T, NC, rk;
    __host__ __device__ bool next(int i, Unit& u) const { const int per = 4 * T, L = i * NC + rk; if (L >= 4 * per) return false; const int l = L / per, r = L - l * per;
        u.pm = l * T + (r >> 2); u.pn = 4 * l + (r & 3); return true; }
    __device__ __forceinline__ void a_ready(const Unit&) const {}
    __device__ __forceinline__ void done(const Unit&) const {}
};
#ifndef GEMM_DMA_IN_MMA
#define GEMM_DMA_IN_MMA 0
#endif
#ifndef GEMM_XMFMA
#define GEMM_XMFMA 0
#endif
template <class Epi, class Sched, bool ALIGN_EPI = false, bool SP2 = false>
__device__ __forceinline__ void gemm_phase(PG8_LAS unsigned char* lds, const Gemm g, const Sched& S, const Epi& E) {
    int tid_ = threadIdx.x; asm volatile("" : "+v"(tid_));
    const int tid = tid_, wid = __builtin_amdgcn_readfirstlane(tid >> 6), lane = tid & 63, wr = wid >> 2, wc = wid & 3, fr = lane & 15, fq = lane >> 4;
    constexpr bool DMA_IN_MMA = SP2 && (GEMM_DMA_IN_MMA != 0);
    const int K = g.K, nt = K / BK;
    unsigned voffA[2], voffB[2];
#pragma unroll
    for (int i = 0; i < 2; ++i) { int R, C; stage_rc(tid * 16 + i * 8192, R, C); const int Rb = Epi::PERM ? ((R & ~31) + perm32(R & 31)) : R;
        voffA[i] = (unsigned)(R * K + C) * 2u; voffB[i] = (unsigned)(Rb * K + C) * 2u; }
    const size_t kstep = (size_t)(BK * 2);
    const size_t hstep = (size_t)HALF * K * 2;
    const size_t tstep = 2 * hstep;
    const unsigned ldsw = (unsigned)wid * 1024u;
    const int aoff = lds_byte(wr * 64 + fr, fq * 8), boff = lds_byte(wc * 32 + fr, fq * 8);
#define PG8_SA(b, h) (((b) * 2 + (h)) * HTB)
#define PG8_SB(b, h) ((4 + (b) * 2 + (h)) * HTB)
#define PG8_STAGE(bufoff, gbase, voff) do { _Pragma("unroll") for (int _i = 0; _i < 2; ++_i) \
        __builtin_amdgcn_global_load_lds((const unsigned*)((const char*)(gbase) + (voff)[_i]), (PG8_LAS unsigned*)(lds + (bufoff) + ldsw + _i * 8192), 16, 0, 0); } while (0)
#define PG8_LDA(dst, b, h) do { _Pragma("unroll") for (int m = 0; m < 4; ++m) _Pragma("unroll") for (int k = 0; k < 2; ++k) dst[m][k] = *(const PG8_LAS bf16x8*)(lds + PG8_SA(b, h) + aoff + m * 2048 + k * 1024); } while (0)
#define PG8_LDB(dst, b, h) do { _Pragma("unroll") for (int n = 0; n < 2; ++n) _Pragma("unroll") for (int k = 0; k < 2; ++k) dst[n][k] = *(const PG8_LAS bf16x8*)(lds + PG8_SB(b, h) + boff + n * 2048 + k * 1024); } while (0)
#define PG8_MMA(ai, bj, At, Bt) do { __builtin_amdgcn_s_setprio(1); _Pragma("unroll") for (int m = 0; m < 4; ++m) _Pragma("unroll") for (int n = 0; n < 2; ++n) _Pragma("unroll") for (int k = 0; k < 2; ++k) \
        acc[ai][bj][m][n] = __builtin_amdgcn_mfma_f32_16x16x32_bf16(Bt[n][k], At[m][k], acc[ai][bj][m][n], 0, 0, 0); \
        if (GEMM_XMFMA) { bf16x8 z_ = {0, 0, 0, 0, 0, 0, 0, 0}; asm volatile("" : "+v"(z_)); _Pragma("unroll") for (int m = 0; m < 4; ++m) _Pragma("unroll") for (int n = 0; n < 2; ++n) acc[ai][bj][m][n] = __builtin_amdgcn_mfma_f32_16x16x32_bf16(z_, At[m][0], acc[ai][bj][m][n], 0, 0, 0); } \
        __builtin_amdgcn_s_setprio(0); } while (0)
#define PG8_WAIT_V(n) asm volatile("s_waitcnt vmcnt(" #n ")" ::: "memory")
#define PG8_WAIT_L(n) asm volatile("s_waitcnt lgkmcnt(" #n ")" ::: "memory")
#define PG8_BAR __builtin_amdgcn_s_barrier()
#define PG8_SCHED __builtin_amdgcn_sched_barrier(0)
    Unit cur, nxt; int ui = 0; float epre[8];
    if (!S.next(0, cur)) return;
    f32x4 acc[2][2][4][2];
#pragma unroll
    for (int a = 0; a < 2; ++a)
#pragma unroll
        for (int b = 0; b < 2; ++b)
#pragma unroll
            for (int m = 0; m < 4; ++m)
#pragma unroll
                for (int n = 0; n < 2; ++n) acc[a][b][m][n] = (f32x4){0.f, 0.f, 0.f, 0.f};
    bf16x8 At[4][2], B0[2][2], B1[2][2];
    const char* cA = (const char*)g.A + (size_t)cur.pm * tstep; const char* cB = (const char*)g.Bt + (size_t)cur.pn * tstep;
    S.a_ready(cur);
    E.prefetch(cur, wr, fr, epre);
    if constexpr (SP2) {
        PG8_STAGE(PG8_SB(0, 0), cB, voffB); PG8_STAGE(PG8_SB(0, 1), cB + hstep, voffB); PG8_STAGE(PG8_SA(0, 0), cA, voffA); PG8_STAGE(PG8_SA(0, 1), cA + hstep, voffA);
        if (wr == 1) PG8_BAR;
        PG8_WAIT_V(2); PG8_BAR;
        PG8_STAGE(PG8_SB(1, 0), cB + kstep, voffB); PG8_STAGE(PG8_SA(1, 0), cA + kstep, voffA); PG8_STAGE(PG8_SB(1, 1), cB + hstep + kstep, voffB);
        PG8_WAIT_V(6); PG8_BAR;
    } else {
        PG8_STAGE(PG8_SB(0, 0), cB, voffB); PG8_STAGE(PG8_SA(0, 0), cA, voffA); PG8_STAGE(PG8_SB(0, 1), cB + hstep, voffB); PG8_STAGE(PG8_SA(0, 1), cA + hstep, voffA);
        if (wr == 1) PG8_BAR;
        PG8_WAIT_V(4); PG8_BAR;
        PG8_STAGE(PG8_SB(1, 0), cB + kstep, voffB); PG8_STAGE(PG8_SA(1, 0), cA + kstep, voffA); PG8_STAGE(PG8_SB(1, 1), cB + hstep + kstep, voffB);
        PG8_WAIT_V(6); PG8_BAR;
    }
    for (;;) {
        const bool has_next = S.next(ui + 1, nxt);
        const char* nA = has_next ? (const char*)g.A + (size_t)nxt.pm * tstep : cA; const char* nB = has_next ? (const char*)g.Bt + (size_t)nxt.pn * tstep : cB;
        for (int t = 0; t < nt; t += 2) {
            const bool last = (t == nt - 2);
            const char* a1 = cA + (size_t)(t + 1) * kstep;
            const char* a2 = last ? nA : cA + (size_t)(t + 2) * kstep; const char* b2 = last ? nB : cB + (size_t)(t + 2) * kstep;
            const char* a3 = a2 + kstep; const char* b3 = b2 + kstep;
            if (last && has_next) S.a_ready(nxt);
            if constexpr (SP2) {
            PG8_LDB(B0, 0, 0); PG8_LDB(B1, 0, 1); PG8_SCHED; PG8_LDA(At, 0, 0); PG8_STAGE(PG8_SA(1, 1), a1 + hstep, voffA);
            PG8_WAIT_V(8); PG8_WAIT_L(0); PG8_BAR; PG8_MMA(0, 0, At, B0); PG8_MMA(0, 1, At, B1); PG8_BAR; PG8_SCHED;
            if constexpr (DMA_IN_MMA) {
            PG8_LDA(At, 0, 1);
            PG8_WAIT_V(2); PG8_WAIT_L(0); PG8_BAR; PG8_STAGE(PG8_SB(0, 0), b2, voffB); PG8_SCHED; PG8_MMA(1, 0, At, B0); PG8_SCHED; PG8_STAGE(PG8_SB(0, 1), b2 + hstep, voffB); PG8_SCHED; PG8_MMA(1, 1, At, B1); PG8_SCHED; PG8_STAGE(PG8_SA(0, 0), a2, voffA); PG8_BAR; PG8_SCHED;
            } else {
            PG8_LDA(At, 0, 1); PG8_STAGE(PG8_SB(0, 0), b2, voffB); PG8_STAGE(PG8_SB(0, 1), b2 + hstep, voffB); PG8_STAGE(PG8_SA(0, 0), a2, voffA);
            PG8_WAIT_V(8); PG8_WAIT_L(0); PG8_BAR; PG8_MMA(1, 0, At, B0); PG8_MMA(1, 1, At, B1); PG8_BAR; PG8_SCHED;
            }
            PG8_LDB(B0, 1, 0); PG8_LDB(B1, 1, 1); PG8_SCHED; PG8_LDA(At, 1, 0); PG8_STAGE(PG8_SA(0, 1), a2 + hstep, voffA);
            PG8_WAIT_V(8); PG8_WAIT_L(0); PG8_BAR; PG8_MMA(0, 0, At, B0); PG8_MMA(0, 1, At, B1); PG8_BAR; PG8_SCHED;
            if constexpr (DMA_IN_MMA) {
            PG8_LDA(At, 1, 1);
            PG8_WAIT_V(2); PG8_WAIT_L(0); PG8_BAR; PG8_STAGE(PG8_SB(1, 0), b3, voffB); PG8_SCHED; PG8_MMA(1, 0, At, B0); PG8_SCHED; PG8_STAGE(PG8_SB(1, 1), b3 + hstep, voffB); PG8_SCHED; PG8_MMA(1, 1, At, B1); PG8_SCHED; PG8_STAGE(PG8_SA(1, 0), a3, voffA); PG8_BAR; PG8_SCHED;
            } else {
            PG8_LDA(At, 1, 1); PG8_STAGE(PG8_SB(1, 0), b3, voffB); PG8_STAGE(PG8_SB(1, 1), b3 + hstep, voffB); PG8_STAGE(PG8_SA(1, 0), a3, voffA);
            PG8_WAIT_V(8); PG8_WAIT_L(0); PG8_BAR; PG8_MMA(1, 0, At, B0); PG8_MMA(1, 1, At, B1); PG8_BAR; PG8_SCHED;
            }
            } else {
            PG8_LDB(B0, 0, 0); PG8_SCHED; PG8_LDA(At, 0, 0); PG8_STAGE(PG8_SA(1, 1), a1 + hstep, voffA);
            PG8_WAIT_L(8); PG8_BAR; PG8_WAIT_L(0); PG8_MMA(0, 0, At, B0); PG8_BAR; PG8_SCHED;
            PG8_LDB(B1, 0, 1); PG8_STAGE(PG8_SB(0, 0), b2, voffB);
            PG8_BAR; PG8_WAIT_L(0); PG8_MMA(0, 1, At, B1); PG8_BAR;
            PG8_LDA(At, 0, 1); PG8_STAGE(PG8_SA(0, 0), a2, voffA);
            PG8_BAR; PG8_WAIT_L(0); PG8_MMA(1, 0, At, B0); PG8_BAR; PG8_SCHED;
            PG8_STAGE(PG8_SB(0, 1), b2 + hstep, voffB);
            PG8_WAIT_V(6); PG8_BAR; PG8_MMA(1, 1, At, B1); PG8_BAR;
            PG8_LDB(B0, 1, 0); PG8_SCHED; PG8_LDA(At, 1, 0); PG8_STAGE(PG8_SA(0, 1), a2 + hstep, voffA);
            PG8_WAIT_L(8); PG8_BAR; PG8_WAIT_L(0); PG8_MMA(0, 0, At, B0); PG8_BAR; PG8_SCHED;
            PG8_LDB(B1, 1, 1); PG8_STAGE(PG8_SB(1, 0), b3, voffB);
            PG8_BAR; PG8_WAIT_L(0); PG8_MMA(0, 1, At, B1); PG8_BAR;
            PG8_LDA(At, 1, 1); PG8_STAGE(PG8_SA(1, 0), a3, voffA);
            PG8_BAR; PG8_WAIT_L(0); PG8_MMA(1, 0, At, B0); PG8_BAR; PG8_SCHED;
            PG8_STAGE(PG8_SB(1, 1), b3 + hstep, voffB);
            PG8_WAIT_V(6); PG8_BAR; PG8_MMA(1, 1, At, B1); PG8_BAR;
            }
        }
        if constexpr (ALIGN_EPI) { if (wr == 0) PG8_BAR; }
        if constexpr (!Epi::AFTER_DRAIN) { E(acc, cur, wr, wc, fr, fq, epre); S.done(cur); }
        if (!has_next) break;
#pragma unroll
        for (int a = 0; a < 2; ++a)
#pragma unroll
            for (int b = 0; b < 2; ++b)
#pragma unroll
                for (int m = 0; m < 4; ++m)
#pragma unroll
                    for (int n = 0; n < 2; ++n) acc[a][b][m][n] = (f32x4){0.f, 0.f, 0.f, 0.f};
        cur = nxt; cA = nA; cB = nB; ++ui;
        E.prefetch(cur, wr, fr, epre);
        if constexpr (ALIGN_EPI) { if (wr == 1) PG8_BAR; }
    }
    PG8_WAIT_V(0);
    if constexpr (!ALIGN_EPI) { if (wr == 0) PG8_BAR; }
    PG8_BAR;
    if constexpr (Epi::AFTER_DRAIN) { E.fused(acc, cur, wr, wc, fr, fq, lds, wid, lane); S.done(cur); }
#undef PG8_SA
#undef PG8_SB
#undef PG8_STAGE
#undef PG8_LDA
#undef PG8_LDB
#undef PG8_MMA
#undef PG8_WAIT_V
#undef PG8_WAIT_L
#undef PG8_BAR
#undef PG8_SCHED
}
}
namespace att {
#ifndef ATT_XMFMA
#define ATT_XMFMA 0
#endif
#ifndef ATT_STAGGER
#define ATT_STAGGER 0
#endif
#ifndef ATT_XBAR
#define ATT_XBAR 0
#endif
#define ALAS __attribute__((address_space(3)))
typedef short bf16x8 __attribute__((ext_vector_type(8)));
typedef short s16x4 __attribute__((ext_vector_type(4)));
typedef float f32x16 __attribute__((ext_vector_type(16)));
typedef float f32x4 __attribute__((ext_vector_type(4)));
typedef unsigned u32x4 __attribute__((ext_vector_type(4)));
typedef unsigned short bf16_t;
constexpr int NW = 8, QBLK = 32, KVBLK = 64, QB = NW * QBLK;
constexpr int SHM_V = KVBLK * 128 * 2, SHM_K = KVBLK * 128 * 2;
constexpr int OFF_V = 0, OFF_K = 2 * SHM_V, OFF_WS = OFF_K + 2 * SHM_K, OFF_CUM = OFF_WS + NW * 64 * 4, OFF_MISC = OFF_CUM + 2048 * 4, ATT_LDS_BYTES = OFF_MISC + 256;
constexpr float LOG2E = 1.4426950408889634f;
#define KSWZ(row, colB) ((row) * 256 + ((colB) ^ (((row) & 7) << 4)))
#define SBAR() __builtin_amdgcn_sched_barrier(0)
__device__ __forceinline__ int v_st(int k, int c) { const int kk = (k & ~0xC) | ((k & 4) << 1) | ((k & 8) >> 1); return ((kk >> 3) * 4 + (c >> 5)) * 512 + ((kk & 7) * 32 + (c & 31)) * 2; }
__device__ __forceinline__ int v_rd_base(int lane) { return ((lane & 3) << 3) | (((lane >> 2) & 3) << 6) | (((lane >> 4) & 1) << 5) | (((lane >> 5) & 1) << 8); }
constexpr int v_rd_off(int d0, int ks, int half) { return d0 * 512 + ks * 4096 + half * 2048; }
__device__ __forceinline__ int crow(int r, int hi) { return (r & 3) + 8 * (r >> 2) + 4 * hi; }
__device__ __forceinline__ unsigned cvtpk(float lo, float hi) { unsigned r; asm volatile("v_cvt_pk_bf16_f32 %0, %1, %2" : "=v"(r) : "v"(lo), "v"(hi)); return r; }
__device__ __forceinline__ void mask_tile(f32x16& p0, f32x16& p1, int dq) {
    const float NEG = -__builtin_inff();
#pragma unroll
    for (int r = 0; r < 16; ++r) { const int c = (r & 3) + 8 * (r >> 2);
        if (dq - c < 0) p0[r] = NEG;
        if (dq - c - 32 < 0) p1[r] = NEG; }
}
__device__ __forceinline__ void pack_p(const f32x16& p0, const f32x16& p1, bf16x8& pa0, bf16x8& pa1, bf16x8& pa2, bf16x8& pa3) {
#define PK4(P, B_, OUT) do { unsigned a0 = cvtpk(P[B_+0], P[B_+1]), a1 = cvtpk(P[B_+2], P[B_+3]); unsigned b0 = cvtpk(P[B_+4], P[B_+5]), b1 = cvtpk(P[B_+6], P[B_+7]); \
        auto r0 = __builtin_amdgcn_permlane32_swap(a0, b0, false, false); auto r1 = __builtin_amdgcn_permlane32_swap(a1, b1, false, false); \
        u32x4 w = {r0[0], r1[0], r0[1], r1[1]}; OUT = __builtin_bit_cast(bf16x8, w); } while (0)
    PK4(p0, 0, pa0); PK4(p0, 8, pa1); PK4(p1, 0, pa2); PK4(p1, 8, pa3);
#undef PK4
}
template <int KB, int ND>
__device__ __forceinline__ void qkt(f32x16& p0, f32x16& p1, const ALAS char* K_lds, int r32, int hi, const bf16x8* qr, int koff) {
    p0 = f32x16{}; p1 = f32x16{};
    const ALAS char* kb[4];
#pragma unroll
    for (int dd = 0; dd < 4; ++dd) kb[dd] = K_lds + KB * SHM_K + KSWZ(r32, (dd * 16 + hi * 8) * 2) + koff;
#pragma unroll
    for (int d0 = 0; d0 < ND; ++d0) { const ALAS char* a = kb[d0 & 3] + (d0 >> 2) * 128;
        const bf16x8 b0 = *(const ALAS bf16x8*)(a);
        const bf16x8 b1 = *(const ALAS bf16x8*)(a + 32 * 256);
        p0 = __builtin_amdgcn_mfma_f32_32x32x16_bf16(b0, qr[d0], p0, 0, 0, 0);
        p1 = __builtin_amdgcn_mfma_f32_32x32x16_bf16(b1, qr[d0], p1, 0, 0, 0);
        if (ATT_XMFMA && d0 < 4) { bf16x8 z = {0, 0, 0, 0, 0, 0, 0, 0}; asm volatile("" : "+v"(z));
            p0 = __builtin_amdgcn_mfma_f32_32x32x16_bf16(b0, z, p0, 0, 0, 0); p1 = __builtin_amdgcn_mfma_f32_32x32x16_bf16(b1, z, p1, 0, 0, 0); } }
}
template <int VB>
__device__ __forceinline__ void pv_tile(f32x16* o, int vb0, bf16x8 pa0, bf16x8 pa1, bf16x8 pa2, bf16x8 pa3) {
#define TRRD(dst, off) asm volatile("ds_read_b64_tr_b16 %0, %1 offset:%2" : "=&v"(dst) : "v"(vb0), "i"(off) : "memory")
#define PV_D0(d0) do { s16x4 l0, l1, l2, l3, h0, h1, h2, h3; constexpr int b_ = VB * SHM_V + v_rd_off(d0, 0, 0); \
        TRRD(l0, b_); TRRD(h0, b_ + 2048); TRRD(l1, b_ + 4096); TRRD(h1, b_ + 6144); TRRD(l2, b_ + 8192); TRRD(h2, b_ + 10240); TRRD(l3, b_ + 12288); TRRD(h3, b_ + 14336); \
        asm volatile("s_waitcnt lgkmcnt(0)" ::: "memory"); SBAR(); \
        o[d0] = __builtin_amdgcn_mfma_f32_32x32x16_bf16(pa0, (bf16x8){l0[0], l0[1], l0[2], l0[3], h0[0], h0[1], h0[2], h0[3]}, o[d0], 0, 0, 0); \
        o[d0] = __builtin_amdgcn_mfma_f32_32x32x16_bf16(pa1, (bf16x8){l1[0], l1[1], l1[2], l1[3], h1[0], h1[1], h1[2], h1[3]}, o[d0], 0, 0, 0); \
        o[d0] = __builtin_amdgcn_mfma_f32_32x32x16_bf16(pa2, (bf16x8){l2[0], l2[1], l2[2], l2[3], h2[0], h2[1], h2[2], h2[3]}, o[d0], 0, 0, 0); \
        o[d0] = __builtin_amdgcn_mfma_f32_32x32x16_bf16(pa3, (bf16x8){l3[0], l3[1], l3[2], l3[3], h3[0], h3[1], h3[2], h3[3]}, o[d0], 0, 0, 0); } while (0)
    PV_D0(0); PV_D0(1); PV_D0(2); PV_D0(3);
#undef PV_D0
#undef TRRD
}
__device__ __forceinline__ float swap_max(float v) { auto rr = __builtin_amdgcn_permlane32_swap(__float_as_uint(v), __float_as_uint(v), false, false); return fmaxf(__uint_as_float(rr[0]), __uint_as_float(rr[1])); }
__device__ __forceinline__ float swap_sum(float v) { auto rr = __builtin_amdgcn_permlane32_swap(__float_as_uint(v), __float_as_uint(v), false, false); return __uint_as_float(rr[0]) + __uint_as_float(rr[1]); }

__device__ __forceinline__ void store_o(const f32x16* o, const float* rli, bf16_t* Ow, int op, ALAS char* lds, int wid, int lane, int r32, int hi) {
    __syncthreads();
    ALAS char* stg = lds + wid * 8192;
#pragma unroll
    for (int r = 0; r < 16; ++r) { const int orow = crow(r, hi);
#pragma unroll
        for (int d0 = 0; d0 < 4; ++d0) { const float v = o[d0][r] * rli[r]; const float vn = __shfl_xor(v, 1);
            if ((r32 & 1) == 0) *(ALAS unsigned*)(stg + orow * 256 + (d0 * 32 + r32) * 2) = cvtpk(v, vn); } }
    asm volatile("s_waitcnt lgkmcnt(0)" ::: "memory");
#pragma unroll
    for (int i = 0; i < 8; ++i) { const int row = i * 4 + (lane >> 4), ch = lane & 15; const u32x4 v = *(const ALAS u32x4*)(stg + row * 256 + ch * 16); *(u32x4*)(Ow + (size_t)row * op + ch * 8) = v; }
    __syncthreads();
}
template <int MODE>
__device__ __forceinline__ void attn_unit(const bf16_t* Q, int qp, const bf16_t* K, const bf16_t* V, int kvp, bf16_t* O, int op, int pos0, int NT, int koff, const float* logf, ALAS char* lds) {
    constexpr int ND = (MODE == 0) ? 4 : 8;
    constexpr bool CAUSAL = (MODE != 3), SB = (MODE == 1);
    constexpr float SCALE = (MODE == 0) ? 0.125f : 0.08838834764831845f;
    constexpr float C2 = SCALE * LOG2E;
    constexpr float THR2 = 8.f * LOG2E;
    int tid_ = threadIdx.x; asm volatile("" : "+v"(tid_));
    const int tid = tid_, wid = __builtin_amdgcn_readfirstlane(tid >> 6), lane = tid & 63, r32 = lane & 31, hi = lane >> 5;
    const ALAS char* V_lds = lds + OFF_V; const ALAS char* K_lds = lds + OFF_K;
    ALAS float* wsf = (ALAS float*)(lds + OFF_WS) + wid * 64; ALAS float* li_l = wsf; ALAS float* al_l = wsf + 32;
    ALAS float* cum2 = (ALAS float*)(lds + OFF_CUM);
    const int sr = tid >> 4, sc = (tid & 15) * 8, vst0 = v_st(sr, sc), vst1 = v_st(32 + sr, sc), kws = KSWZ(sr, sc * 2);
    const int vb0 = (int)(uintptr_t)(V_lds) + v_rd_base(lane);
    float cq2 = 0.f;
    if constexpr (MODE == 2) {
        const f32x4 v = *(const f32x4*)(logf + 4 * tid);
        const float a0 = v[0], a1 = a0 + v[1], a2 = a1 + v[2], a3 = a2 + v[3];
        float s = a3;
#pragma unroll
        for (int off = 1; off < 64; off <<= 1) { const float t = __shfl_up(s, off); if (lane >= off) s += t; }
        ALAS float* wt = (ALAS float*)(lds + OFF_MISC) + 16;
        if (lane == 63) wt[wid] = s;
        __syncthreads();
        float base = 0.f;
#pragma unroll
        for (int w = 0; w < NW; ++w) { const float t = wt[w]; if (w < wid) base += t; }
        const float ex = s - a3 + base;
        f32x4 c; c[0] = (ex + a0) * LOG2E; c[1] = (ex + a1) * LOG2E; c[2] = (ex + a2) * LOG2E; c[3] = (ex + a3) * LOG2E;
        *(ALAS f32x4*)(cum2 + 4 * tid) = c;
        __syncthreads();
        cq2 = cum2[pos0 + wid * QBLK + r32];
    }
    bf16x8 qr[ND];
#pragma unroll
    for (int d0 = 0; d0 < ND; ++d0) qr[d0] = *(const bf16x8*)(Q + (size_t)(wid * QBLK + r32) * qp + d0 * 16 + hi * 8);
    const int qlo = pos0 + wid * QBLK;
    const int qm = pos0 + wid * QBLK + r32 - 4 * hi - (SB ? 1 : 0);
    float m_reg = -1e30f, l_reg = 0.f, carry = 0.f; f32x16 o[4] = {};
    bf16x8 st_k0, st_k1, st_v0, st_v1;
#define TILE_OF(it) (SB ? (NT - 1 - (it)) : (it))
#define GROW(p, k0, rr) ((p) + (size_t)((k0) + (rr)) * kvp + sc)
#define SLOAD(k0) do { st_v0 = *(const bf16x8*)GROW(V, k0, sr); st_v1 = *(const bf16x8*)GROW(V, k0, 32 + sr); st_k0 = *(const bf16x8*)GROW(K, k0, sr); st_k1 = *(const bf16x8*)GROW(K, k0, 32 + sr); } while (0)
#define SWRITE(bf) do { *(ALAS bf16x8*)(lds + OFF_K + (bf) * SHM_K + kws) = st_k0; *(ALAS bf16x8*)(lds + OFF_K + (bf) * SHM_K + kws + 32 * 256) = st_k1; \
                        *(ALAS bf16x8*)(lds + OFF_V + (bf) * SHM_V + vst0) = st_v0; *(ALAS bf16x8*)(lds + OFF_V + (bf) * SHM_V + vst1) = st_v1; } while (0)
    SLOAD(TILE_OF(0) * KVBLK); SWRITE(0);
    __syncthreads();
    f32x16 p0, p1; bf16x8 pa0, pa1, pa2, pa3; bool wdone = false, stop = false;
    ALAS unsigned* dflag = (ALAS unsigned*)(lds + OFF_MISC + 128);
#define STEP(it, BUF) do { \
        const int kb_ = TILE_OF(it) * KVBLK; \
        if ((it) + 1 < NT) SLOAD(TILE_OF((it) + 1) * KVBLK); \
          \
        const bool act_ = SB ? (kb_ < qlo + QBLK - 1 && !wdone) : (CAUSAL ? (kb_ <= qlo + QBLK - 1) : true); \
        if (act_) { \
        SBAR(); qkt<BUF, ND>(p0, p1, K_lds, r32, hi, qr, koff); SBAR(); \
        if constexpr (SB) { \
            _Pragma("unroll") for (int r = 0; r < 16; ++r) { p0[r] *= C2; p1[r] *= C2; } \
            if (kb_ + KVBLK - 1 > qlo - 1) mask_tile(p0, p1, qm - kb_); \
            float G0[4], G1[4]; \
            _Pragma("unroll") for (int g = 0; g < 4; ++g) { float s0 = 0.f, s1 = 0.f; \
                _Pragma("unroll") for (int k = 3; k >= 0; --k) { const int r = 4 * g + k; \
                    { const float z = p0[r]; const float sp = fmaxf(z, 0.f) + __builtin_amdgcn_logf(1.0f + __builtin_amdgcn_exp2f(-fabsf(z))); p0[r] = (z - sp) + s0; s0 -= sp; } \
                    { const float z = p1[r]; const float sp = fmaxf(z, 0.f) + __builtin_amdgcn_logf(1.0f + __builtin_amdgcn_exp2f(-fabsf(z))); p1[r] = (z - sp) + s1; s1 -= sp; } } \
                G0[g] = s0; G1[g] = s1; } \
            float run = carry; float offv[8]; \
            _Pragma("unroll") for (int b = 7; b >= 0; --b) { const float gsum = (b >= 4) ? G1[b - 4] : G0[b]; \
                auto rr = __builtin_amdgcn_permlane32_swap(__float_as_uint(gsum), __float_as_uint(gsum), false, false); \
                const float glo = __uint_as_float(rr[0]), ghi = __uint_as_float(rr[1]); \
                offv[b] = run + (hi == 0 ? ghi : 0.f); run += glo + ghi; } \
            carry = run; wdone = __all(carry < -152.0f);     \
            _Pragma("unroll") for (int r = 0; r < 16; ++r) { p0[r] = __builtin_amdgcn_exp2f(p0[r] + offv[r >> 2]); p1[r] = __builtin_amdgcn_exp2f(p1[r] + offv[4 + (r >> 2)]); } \
        } else { \
            if constexpr (MODE == 2) { \
                _Pragma("unroll") for (int g = 0; g < 4; ++g) { const f32x4 c0 = *(const ALAS f32x4*)(cum2 + kb_ + 8 * g + 4 * hi); const f32x4 c1 = *(const ALAS f32x4*)(cum2 + kb_ + 32 + 8 * g + 4 * hi); \
                    _Pragma("unroll") for (int k = 0; k < 4; ++k) { p0[4 * g + k] = fmaf(p0[4 * g + k], C2, cq2 - c0[k]); p1[4 * g + k] = fmaf(p1[4 * g + k], C2, cq2 - c1[k]); } } \
            } else { _Pragma("unroll") for (int r = 0; r < 16; ++r) { p0[r] *= C2; p1[r] *= C2; } } \
            if constexpr (CAUSAL) { if (kb_ + KVBLK - 1 > qlo) mask_tile(p0, p1, qm - kb_); } \
            float pmax = p0[0]; \
            _Pragma("unroll") for (int r = 1; r < 16; ++r) pmax = fmaxf(pmax, p0[r]); \
            _Pragma("unroll") for (int r = 0; r < 16; ++r) pmax = fmaxf(pmax, p1[r]); \
            pmax = swap_max(pmax); \
            float mn, alpha; \
            if (__all(pmax - m_reg <= THR2)) { mn = m_reg; alpha = 1.f; } \
            else { mn = fmaxf(m_reg, pmax); alpha = __builtin_amdgcn_exp2f(m_reg - mn); m_reg = mn; } \
            float ps = 0.f; \
            _Pragma("unroll") for (int r = 0; r < 16; ++r) { p0[r] = __builtin_amdgcn_exp2f(p0[r] - mn); p1[r] = __builtin_amdgcn_exp2f(p1[r] - mn); ps += p0[r] + p1[r]; } \
            ps = swap_sum(ps); l_reg = l_reg * alpha + ps; \
            if (__any(alpha < 1.f)) { if (hi == 0) al_l[r32] = alpha; asm volatile("s_waitcnt lgkmcnt(0)" ::: "memory"); \
                _Pragma("unroll") for (int d_ = 0; d_ < 4; ++d_) _Pragma("unroll") for (int r = 0; r < 16; ++r) o[d_][r] *= al_l[crow(r, hi)]; } \
        } \
        pack_p(p0, p1, pa0, pa1, pa2, pa3); SBAR(); \
        pv_tile<BUF>(o, vb0, pa0, pa1, pa2, pa3); SBAR(); \
        } \
        if ((it) + 1 < NT) SWRITE((BUF) ^ 1); \
        if constexpr (SB) { if (lane == 0) dflag[(BUF) * 8 + wid] = wdone ? 1u : 0u; } \
        __syncthreads(); \
        if constexpr (SB) { const u32x4 f0 = *(const ALAS u32x4*)(dflag + (BUF) * 8), f1 = *(const ALAS u32x4*)(dflag + (BUF) * 8 + 4); \
            stop = ((f0[0] & f0[1] & f0[2] & f0[3] & f1[0] & f1[1] & f1[2] & f1[3]) != 0u); } \
        } while (0)
    for (int it = 0; it < NT; it += 2) { STEP(it, 0); if (stop) break; STEP(it + 1, 1); if (stop) break; }
#undef STEP
#undef SWRITE
#undef SLOAD
#undef GROW
#undef TILE_OF
    float rli[16];
    if constexpr (SB) {
#pragma unroll
        for (int r = 0; r < 16; ++r) rli[r] = 1.f;
    } else {
        if (hi == 0) li_l[r32] = l_reg; asm volatile("s_waitcnt lgkmcnt(0)" ::: "memory");
#pragma unroll
        for (int r = 0; r < 16; ++r) rli[r] = __builtin_amdgcn_rcpf(li_l[crow(r, hi)]);
    }
    store_o(o, rli, O + (size_t)(wid * QBLK) * op, op, lds, wid, lane, r32, hi);
}

template <int MODE>
__device__ __forceinline__ void partialSM(f32x16& p0, f32x16& p1, float& m_reg, float& alpha) {
    constexpr float SCALE = (MODE == 0) ? 0.125f : 0.08838834764831845f;
    constexpr float CS = (MODE == 2) ? 1.0f : SCALE * LOG2E, THR2 = 8.f * LOG2E;
    float pmax = p0[0];
#pragma unroll
    for (int r = 1; r < 16; ++r) pmax = fmaxf(pmax, p0[r]);
#pragma unroll
    for (int r = 0; r < 16; ++r) pmax = fmaxf(pmax, p1[r]);
    pmax = swap_max(pmax);
    float mn;
    if (__builtin_expect(__all((pmax - m_reg) * CS <= THR2), 1)) { mn = m_reg; alpha = 1.f; }
    else { mn = fmaxf(m_reg, pmax); alpha = __builtin_amdgcn_exp2f((m_reg - mn) * CS); m_reg = mn; }
    const float mnL = -mn * CS;
#pragma unroll
    for (int r = 0; r < 16; ++r) { p0[r] = fmaf(p0[r], CS, mnL); p1[r] = fmaf(p1[r], CS, mnL); }
#pragma unroll
    for (int r = 0; r < 16; ++r) p0[r] = __builtin_amdgcn_exp2f(p0[r]);
}
__device__ __forceinline__ void finishSM(f32x16& p0, f32x16& p1, float alpha, float& l_reg, bf16x8& pa0, bf16x8& pa1, bf16x8& pa2, bf16x8& pa3) {
#pragma unroll
    for (int r = 0; r < 16; ++r) p1[r] = __builtin_amdgcn_exp2f(p1[r]);
    float ps = 0.f;
#pragma unroll
    for (int r = 0; r < 16; ++r) ps += p0[r];
#pragma unroll
    for (int r = 0; r < 16; ++r) ps += p1[r];
    ps = swap_sum(ps);
    l_reg = l_reg * alpha + ps;
    pack_p(p0, p1, pa0, pa1, pa2, pa3);
}
template <int MODE, bool LEAD>
__device__ __forceinline__ void attn_unit_sm_(const bf16_t* Q, int qp, const bf16_t* K, const bf16_t* V, int kvp, bf16_t* O, int op, int pos0, int NT, int koff, const float* logf, ALAS char* lds) {
    static_assert(MODE == 0 || MODE == 2 || MODE == 3, "softmax modes");
    constexpr int ND = (MODE == 0) ? 4 : 8;
    constexpr bool CAUSAL = (MODE != 3);
    constexpr float C2 = 0.08838834764831845f * LOG2E;
    int tid_ = threadIdx.x; asm volatile("" : "+v"(tid_));
    const int tid = tid_, wid = __builtin_amdgcn_readfirstlane(tid >> 6), lane = tid & 63, r32 = lane & 31, hi = lane >> 5;
    const ALAS char* V_lds = lds + OFF_V; const ALAS char* K_lds = lds + OFF_K;
    ALAS float* wsf = (ALAS float*)(lds + OFF_WS) + wid * 64; ALAS float* li_l = wsf; ALAS float* al_l = wsf + 32;
    ALAS float* cum2 = (ALAS float*)(lds + OFF_CUM);
    const int sr = tid >> 4, sc = (tid & 15) * 8, vst0 = v_st(sr, sc), vst1 = v_st(32 + sr, sc), kws = KSWZ(sr, sc * 2);
    const int vb0 = (int)(uintptr_t)(V_lds) + v_rd_base(lane);
    float cq2 = 0.f;
    if constexpr (MODE == 2) {
        const f32x4 v = *(const f32x4*)(logf + 4 * tid);
        const float a0 = v[0], a1 = a0 + v[1], a2 = a1 + v[2], a3 = a2 + v[3];
        float s = a3;
#pragma unroll
        for (int off = 1; off < 64; off <<= 1) { const float t = __shfl_up(s, off); if (lane >= off) s += t; }
        ALAS float* wt = (ALAS float*)(lds + OFF_MISC) + 16;
        if (lane == 63) wt[wid] = s;
        __syncthreads();
        float base = 0.f;
#pragma unroll
        for (int w = 0; w < NW; ++w) { const float t = wt[w]; if (w < wid) base += t; }
        const float ex = s - a3 + base;
        f32x4 c; c[0] = (ex + a0) * LOG2E; c[1] = (ex + a1) * LOG2E; c[2] = (ex + a2) * LOG2E; c[3] = (ex + a3) * LOG2E;
        *(ALAS f32x4*)(cum2 + 4 * tid) = c;
        __syncthreads();
        cq2 = cum2[pos0 + wid * QBLK + r32];
    }
    bf16x8 qr[ND];
#pragma unroll
    for (int d0 = 0; d0 < ND; ++d0) qr[d0] = *(const bf16x8*)(Q + (size_t)(wid * QBLK + r32) * qp + d0 * 16 + hi * 8);
    const int qlo = pos0 + wid * QBLK, qm = qlo + r32 - 4 * hi;
    float m_reg = -1e30f, l_reg = 0.f; f32x16 o[4] = {};
    bf16x8 st_k0, st_k1, st_v0, st_v1;
#define GROW(p, k0, rr) ((p) + (size_t)((k0) + (rr)) * kvp + sc)
#define SLOAD(k0) do { st_v0 = *(const bf16x8*)GROW(V, k0, sr); st_v1 = *(const bf16x8*)GROW(V, k0, 32 + sr); st_k0 = *(const bf16x8*)GROW(K, k0, sr); st_k1 = *(const bf16x8*)GROW(K, k0, 32 + sr); } while (0)
#define SWRITE(bf) do { *(ALAS bf16x8*)(lds + OFF_K + (bf) * SHM_K + kws) = st_k0; *(ALAS bf16x8*)(lds + OFF_K + (bf) * SHM_K + kws + 32 * 256) = st_k1; \
                        *(ALAS bf16x8*)(lds + OFF_V + (bf) * SHM_V + vst0) = st_v0; *(ALAS bf16x8*)(lds + OFF_V + (bf) * SHM_V + vst1) = st_v1; } while (0)
#define RESC(a) do { if (__any((a) < 1.f)) { if (hi == 0) al_l[r32] = (a); asm volatile("s_waitcnt lgkmcnt(0)" ::: "memory"); \
        _Pragma("unroll") for (int d_ = 0; d_ < 4; ++d_) _Pragma("unroll") for (int r = 0; r < 16; ++r) o[d_][r] *= al_l[crow(r, hi)]; } } while (0)
#define PREP(P0_, P1_, t) do { const int kb_ = (t) * KVBLK; \
        if constexpr (MODE == 2) { \
            _Pragma("unroll") for (int g = 0; g < 4; ++g) { const f32x4 c0 = *(const ALAS f32x4*)(cum2 + kb_ + 8 * g + 4 * hi); const f32x4 c1 = *(const ALAS f32x4*)(cum2 + kb_ + 32 + 8 * g + 4 * hi); \
                _Pragma("unroll") for (int k = 0; k < 4; ++k) { P0_[4 * g + k] = fmaf(P0_[4 * g + k], C2, cq2 - c0[k]); P1_[4 * g + k] = fmaf(P1_[4 * g + k], C2, cq2 - c1[k]); } } } \
        if constexpr (CAUSAL) { if (kb_ + KVBLK - 1 > qlo) mask_tile(P0_, P1_, qm - kb_); } } while (0)
    f32x16 pA0, pA1, pB0, pB1; float alA, alB; bf16x8 pa0, pa1, pa2, pa3;
    SLOAD(0); SWRITE(0);
    __syncthreads();
    SLOAD(KVBLK);
    SBAR(); qkt<0, ND>(pA0, pA1, K_lds, r32, hi, qr, koff);
    PREP(pA0, pA1, 0); partialSM<MODE>(pA0, pA1, m_reg, alA);
    SWRITE(1);
    __syncthreads();
#define HALF_STEP(PX0, PX1, alX, PY0, PY1, alY, t, KB, VB, SBUF) do { \
        if ((t) + 1 < NT) { SLOAD(((t) + 1) * KVBLK); } \
          \
        if constexpr (LEAD) { \
            SBAR(); qkt<KB, ND>(PX0, PX1, K_lds, r32, hi, qr, koff); SBAR(); \
            finishSM(PY0, PY1, alY, l_reg, pa0, pa1, pa2, pa3); SBAR(); \
            pv_tile<VB>(o, vb0, pa0, pa1, pa2, pa3); SBAR(); \
            PREP(PX0, PX1, (t)); partialSM<MODE>(PX0, PX1, m_reg, alX); SBAR(); \
        } else { \
            SBAR(); finishSM(PY0, PY1, alY, l_reg, pa0, pa1, pa2, pa3); SBAR(); \
            qkt<KB, ND>(PX0, PX1, K_lds, r32, hi, qr, koff); SBAR(); \
            PREP(PX0, PX1, (t)); partialSM<MODE>(PX0, PX1, m_reg, alX); SBAR(); \
            pv_tile<VB>(o, vb0, pa0, pa1, pa2, pa3); SBAR(); \
        } \
        __syncthreads(); \
        if ((t) + 1 < NT) { SWRITE(SBUF); } \
        RESC(alX); __syncthreads(); if (ATT_XBAR) __syncthreads(); } while (0)
    for (int t = 1; t + 1 < NT; t += 2) {
        HALF_STEP(pB0, pB1, alB, pA0, pA1, alA, t, 1, 0, 0);
        HALF_STEP(pA0, pA1, alA, pB0, pB1, alB, t + 1, 0, 1, 1);
    }
    SBAR(); qkt<1, ND>(pB0, pB1, K_lds, r32, hi, qr, koff); SBAR();
    finishSM(pA0, pA1, alA, l_reg, pa0, pa1, pa2, pa3); SBAR();
    pv_tile<0>(o, vb0, pa0, pa1, pa2, pa3);
    PREP(pB0, pB1, NT - 1); partialSM<MODE>(pB0, pB1, m_reg, alB); RESC(alB);
    finishSM(pB0, pB1, alB, l_reg, pa0, pa1, pa2, pa3); SBAR();
    pv_tile<1>(o, vb0, pa0, pa1, pa2, pa3);
#undef HALF_STEP
#undef PREP
#undef RESC
#undef SWRITE
#undef SLOAD
#undef GROW
    if (hi == 0) li_l[r32] = l_reg; asm volatile("s_waitcnt lgkmcnt(0)" ::: "memory");
    float rli[16];
#pragma unroll
    for (int r = 0; r < 16; ++r) rli[r] = __builtin_amdgcn_rcpf(li_l[crow(r, hi)]);
    store_o(o, rli, O + (size_t)(wid * QBLK) * op, op, lds, wid, lane, r32, hi);
}
template <int MODE>
__device__ __forceinline__ void attn_unit_sm(const bf16_t* Q, int qp, const bf16_t* K, const bf16_t* V, int kvp, bf16_t* O, int op, int pos0, int NT, int koff, const float* logf, ALAS char* lds) {
    const int wid = __builtin_amdgcn_readfirstlane((int)threadIdx.x >> 6);
    if (!ATT_STAGGER || wid < 4) attn_unit_sm_<MODE, true>(Q, qp, K, V, kvp, O, op, pos0, NT, koff, logf, lds);
    else attn_unit_sm_<MODE, false>(Q, qp, K, V, kvp, O, op, pos0, NT, koff, logf, lds);
}
#undef SBAR
#undef KSWZ
}
#define GAS __attribute__((address_space(1)))
#define LAS __attribute__((address_space(3)))
typedef unsigned short bf16;
typedef unsigned v4u __attribute__((ext_vector_type(4)));
typedef float f32x4 __attribute__((ext_vector_type(4)));
typedef short bf16x8 __attribute__((ext_vector_type(8)));
typedef GAS unsigned gu32;
typedef GAS unsigned long long gu64;
#define RLX_AGENT __ATOMIC_RELAXED, __HIP_MEMORY_SCOPE_AGENT
#define LDS_WAIT() asm volatile("s_waitcnt lgkmcnt(0)" ::: "memory")
#define VM_WAIT() asm volatile("s_waitcnt vmcnt(0)" ::: "memory")
__device__ __forceinline__ unsigned long long rt() { return __builtin_amdgcn_s_memrealtime(); }
__device__ __forceinline__ unsigned f2bf(float f) { unsigned u = __builtin_bit_cast(unsigned, f); return (u + 0x7fffu + ((u >> 16) & 1u)) >> 16; }
__device__ __forceinline__ unsigned pk2(float lo, float hi) { return f2bf(lo) | (f2bf(hi) << 16); }

#define XB_TMO      128
#define XB_XCNT(j)  (256  + 64 * (j))
#define XB_XSUB(j)  (1280 + 64 * (j))
#define XB_XGEN(j)  (2304 + 64 * (j))
#define XB_TOP      3328
#define XB_TOPGEN   3392
#define XCD_BAR_WORDS 3456
#define XB_SPIN_CAP (1u << 18)

__device__ __forceinline__ unsigned xb_ld(unsigned* p)              { return __hip_atomic_load(p, __ATOMIC_RELAXED, __HIP_MEMORY_SCOPE_AGENT); }
__device__ __forceinline__ unsigned xb_add(unsigned* p, unsigned v) { return __hip_atomic_fetch_add(p, v, __ATOMIC_RELAXED, __HIP_MEMORY_SCOPE_AGENT); }
__device__ __forceinline__ unsigned xb_xcc_id() { return (unsigned)__builtin_amdgcn_s_getreg((3 << 11) | 20) & 0xFu; }
#define XB_SPIN(cond, bar) do { unsigned _sp = 0; while (cond) { __builtin_amdgcn_s_sleep(1); \
    if ((++_sp & 255u) == 0u) { if (xb_ld(&(bar)[XB_TMO])) break; if (_sp > XB_SPIN_CAP) { atomicAdd(&(bar)[XB_TMO], 1u); break; } } } } while (0)

#ifndef XB_SKIP_WB_ONE_XCC
#define XB_SKIP_WB_ONE_XCC 1
#endif
struct XcdBarrier {
    unsigned* bar; unsigned x;
    volatile LAS unsigned* st;
    unsigned npart;
};

__device__ __forceinline__ XcdBarrier xcd_barrier_post(unsigned* bar, volatile LAS unsigned* st, unsigned npart = 0u) {
    XcdBarrier b; b.bar = bar; b.x = xb_xcc_id(); b.st = st; b.npart = npart;
    if (threadIdx.x == 0) (void)xb_add(&bar[XB_XCNT(b.x)], 1u);
    return b;
}
__device__ __forceinline__ void xcd_barrier_complete(unsigned* bar, unsigned x, unsigned& nloc, unsigned& nx, unsigned npart) {
    const unsigned G = npart ? npart : gridDim.x * gridDim.y * gridDim.z;
    unsigned sum, cnt, mine, sp = 0u;
    for (;;) {
        sum = 0u; cnt = 0u; mine = 0u;
#pragma unroll
        for (unsigned j = 0; j < 16; ++j) { const unsigned c = xb_ld(&bar[XB_XCNT(j)]); sum += c; cnt += (c > 0u) ? 1u : 0u; mine = (j == x) ? c : mine; }
        if (sum == G) break;
        __builtin_amdgcn_s_sleep(1);
        if ((++sp & 255u) == 0u) { if (xb_ld(&bar[XB_TMO])) break; if (sp > XB_SPIN_CAP) { atomicAdd(&bar[XB_TMO], 1u); break; } }
    }
    nloc = mine > 0u ? mine : 1u; nx = cnt > 0u ? cnt : 1u;
}

__device__ __forceinline__ void xcd_barrier(const XcdBarrier& b) {
    asm volatile("s_waitcnt vmcnt(0)" ::: "memory");
    __syncthreads();
    if (threadIdx.x == 0) {
        unsigned* bar = b.bar;
        __builtin_amdgcn_s_waitcnt(0);
        unsigned nloc = b.st[0], nx = b.st[1];
        if (nloc == 0u) { xcd_barrier_complete(bar, b.x, nloc, nx, b.npart); b.st[0] = nloc; b.st[1] = nx; }
        const unsigned old = xb_add(&bar[XB_XSUB(b.x)], 1u);
        const unsigned gen = old / nloc;
        if (old + 1u == (gen + 1u) * nloc) {
            if (!XB_SKIP_WB_ONE_XCC || nx > 1u)
            __builtin_amdgcn_fence(__ATOMIC_RELEASE, "agent");
            asm volatile("s_waitcnt vmcnt(0)" ::: "memory");
            const unsigned og = xb_add(&bar[XB_TOP], 1u);
            const unsigned tg = og / nx;
            if (og + 1u == (tg + 1u) * nx) xb_add(&bar[XB_TOPGEN], 1u);
            else XB_SPIN(xb_ld(&bar[XB_TOPGEN]) == tg, bar);
            __builtin_amdgcn_fence(__ATOMIC_ACQUIRE, "agent");
            xb_add(&bar[XB_XGEN(b.x)], 1u);
            asm volatile("s_waitcnt vmcnt(0)" ::: "memory");
        } else {
            XB_SPIN(xb_ld(&bar[XB_XGEN(b.x)]) == gen, bar);
            __builtin_amdgcn_fence(__ATOMIC_ACQUIRE, "agent");
            asm volatile("s_waitcnt vmcnt(0)" ::: "memory");
        }
    }
    __syncthreads();
}
constexpr int NWAVES = 8;
constexpr int BATCH = 16, SEQ = 2048, DM = 2048, DEPTH = 4, MEMLEN = 256;
constexpr int M = BATCH * SEQ;
constexpr int MM = BATCH * MEMLEN;
constexpr int NPROJ = 6144, INCOLS = 6150, DFF = 5632, CROSSW = 512;
constexpr int QA_C = 0, KA_C = 512, VA_C = 1024, QB_C = 1536, KB_C = 2304, VB_C = 3072, QC_C = 3840, KC_C = 4608, VC_C = 5376;
constexpr float EPS = 1e-6f;
constexpr int N_PHASES = 1 + 12 * DEPTH;
#ifndef PH_MASK
#define PH_MASK 0x1fff
#endif
#define EN(k) (((PH_MASK) >> (k)) & 1)
#ifndef ATTN_PIPE
#define ATTN_PIPE 1
#endif
#if ATTN_PIPE
#define ATTN_SM attn_unit_sm
#else
#define ATTN_SM attn_unit
#endif
#ifndef DUP_A0
#define DUP_A0 1
#endif
#ifndef DUP_A1
#define DUP_A1 1
#endif
#ifndef DUP_A2
#define DUP_A2 1
#endif
#ifndef CODE_PREFETCH
#define CODE_PREFETCH 1
#endif
#ifndef CODE_PREFETCH_BYTES
#define CODE_PREFETCH_BYTES 200000u
#endif
#ifndef CLASS_PIPE
#define CLASS_PIPE 1
#endif
#ifndef FFN_SPLIT
#define FFN_SPLIT 1
#endif
#ifndef NT_PROJ
#define NT_PROJ 1
#endif
#ifndef DUP_BAR
#define DUP_BAR 0
#endif
#ifndef DUP_T
#define DUP_T 1
#endif
#ifndef N_BARS
#define N_BARS 1
#endif
#ifndef DUP_A
#define DUP_A 1
#endif
#ifndef DUP_GEMM
#define DUP_GEMM 1
#endif
#ifndef GEMM_SP2
#define GEMM_SP2 true
#endif
#ifndef GEMM_ALIGN
#define GEMM_ALIGN true
#endif
#ifndef EN_A0
#define EN_A0 1
#endif
#ifndef EN_A1
#define EN_A1 1
#endif
#ifndef EN_A2
#define EN_A2 1
#endif
#ifndef EN_G0
#define EN_G0 1
#endif
#ifndef ROPE_TILES
#define ROPE_TILES 4
#endif
#ifndef MK_ONE_LAUNCH
#define MK_ONE_LAUNCH 0
#endif

constexpr size_t MiB = 1u << 20;
constexpr size_t WS_CTL = 0, CTL_ZERO_BYTES = 1 * MiB;
constexpr size_t WS_ROPE = 1 * MiB;
constexpr size_t WS_LOGF = 9 * MiB;
constexpr size_t WS_RS = 9 * MiB + 768 * 1024;
constexpr size_t WS_KV = 10 * MiB;
constexpr size_t WS_W = 42 * MiB, W_LAYER = 102 * MiB;
constexpr size_t WO_IN = 0, WO_OUT = 24 * MiB, WO_CQ = 32 * MiB, WO_CO = 34 * MiB, WO_GU = 36 * MiB, WO_DN = 80 * MiB;
constexpr size_t WS_XB = 450 * MiB;
constexpr size_t WS_YB = 578 * MiB;
constexpr size_t WS_MEMN = WS_YB;
constexpr size_t WS_WCKV = 1090 * MiB;
constexpr size_t OUT_O = 0, OUT_OA = 128 * MiB;
constexpr size_t WS_BIG = 706 * MiB;
constexpr size_t WS_QX = WS_BIG, WS_O2 = WS_BIG + 32 * MiB;
constexpr size_t WS_END = 1106 * MiB;
constexpr int CW_TMO = 0, CW_BAR = 4096, CW_Q = 65536;

constexpr int RING_BYTES = 131072, LDSCTL_OFF = RING_BYTES, MISC_OFF = LDSCTL_OFF + 320, LDS_BYTES = 147456;
static_assert(att::ATT_LDS_BYTES <= RING_BYTES, "attention scratch inside the ring region");

__device__ const double kInvFreq[32] = { 1.0, 0.7498942093324559, 0.5623413251903491, 0.4216965034285822, 0.31622776601683794, 0.23713737056616552, 0.1778279410038923, 0.1333521432163324,
    0.1, 0.07498942093324558, 0.05623413251903491, 0.042169650342858224, 0.03162277660168379, 0.023713737056616554, 0.01778279410038923, 0.01333521432163324,
    0.01, 0.007498942093324558, 0.005623413251903491, 0.004216965034285823, 0.0031622776601683794, 0.0023713737056616554, 0.0017782794100389228, 0.001333521432163324,
    0.001, 0.0007498942093324559, 0.0005623413251903491, 0.00042169650342858224, 0.00031622776601683794, 0.00023713737056616554, 0.00017782794100389227, 0.0001333521432163324 };

struct Args {
    const float* x; const float* mem; const int* pos;
    const float *g_mix_pre, *g_mix_post, *w_in, *b_f, *lam_q1, *lam_k1, *lam_q2, *lam_k2, *g_diff_sub, *g_sb_out, *g_fox_out, *w_out;
    const float *g_x_pre, *g_x_post, *g_mem, *w_cq, *w_ckv, *w_co, *g_ffn_pre, *g_ffn_post, *w_gate, *w_up, *w_down;
    float* out; unsigned char* ws; int ph_lo, ph_hi, li, pad;
};

typedef unsigned u32x2 __attribute__((ext_vector_type(2)));
struct Frame { LAS unsigned char* lds; int tid, lane, wave, vcu, G; int rw0, rwend, rwstride; };
#define PHASE_FENCE(F) do { int t_ = threadIdx.x; asm volatile("" : "+v"(t_)); (F).tid = t_; (F).lane = t_ & 63; } while (0)

__device__ __forceinline__ float wave_sum(float v) {
#pragma unroll
    for (int o = 1; o < 64; o <<= 1) v += __shfl_xor(v, o);
    return v;
}
__device__ __forceinline__ unsigned pkbf(float lo, float hi) { return pg8::cvt_pk_bf16(lo, hi); }
__device__ __forceinline__ float bflo(unsigned w) { return __uint_as_float(w << 16); }
__device__ __forceinline__ float bfhi(unsigned w) { return __uint_as_float(w & 0xffff0000u); }

__device__ __forceinline__ void transpose_item(const float* W, int ld, int K, int k0, int scol, bf16* WT, int n0, LAS float* scr, int lane, const float* gain = nullptr) {
#pragma unroll
    for (int i = 0; i < 32; ++i) { const int kk = 2 * i + (lane >> 5); scr[kk * 33 + (lane & 31)] = W[(size_t)(k0 + kk) * ld + scol]; }
    LDS_WAIT(); asm volatile("" ::: "memory");
    const int c = lane & 7;
    f32x4 ga = {1.f, 1.f, 1.f, 1.f}, gb = {1.f, 1.f, 1.f, 1.f};
    if (gain) { ga = *(const GAS f32x4*)(gain + k0 + 8 * c); gb = *(const GAS f32x4*)(gain + k0 + 8 * c + 4); }
#pragma unroll
    for (int j = 0; j < 4; ++j) { const int n = (lane >> 3) + 8 * j; const LAS float* s = scr + (8 * c) * 33 + n;
        v4u o; o.x = pkbf(s[0 * 33] * ga.x, s[1 * 33] * ga.y); o.y = pkbf(s[2 * 33] * ga.z, s[3 * 33] * ga.w); o.z = pkbf(s[4 * 33] * gb.x, s[5 * 33] * gb.y); o.w = pkbf(s[6 * 33] * gb.z, s[7 * 33] * gb.w);
        *(GAS v4u*)(WT + (size_t)(n0 + n) * K + k0 + 8 * c) = o; }
    LDS_WAIT(); asm volatile("" ::: "memory");
}
__device__ __forceinline__ void p0_weights(Frame& F, const Args& a, unsigned char* ws) {
    LAS float* scr = (LAS float*)(F.lds + F.wave * 16384);
    const int gw = F.vcu * NWAVES + F.wave, NGW = F.G * NWAVES, j = F.lane & 31;
    constexpr int I_IN = 32 * 192, I_OUT = 32 * 64, I_CQ = 32 * 16, I_CKV = 32 * 32, I_CO = 8 * 64, I_GU = 32 * 352, I_DN = 88 * 64;
    constexpr int I_LAYER = I_IN + I_OUT + I_CQ + I_CKV + I_CO + I_GU + I_DN;
    for (int it = gw; it < DEPTH * I_LAYER; it += NGW) {
        const int l = it / I_LAYER; int r = it - l * I_LAYER;
        unsigned char* wl = ws + WS_W + (size_t)l * W_LAYER;
        if (r < I_IN) { const int kb = r / 192, nb = r % 192, n = 32 * nb + j; int sc = n; if (n < 1024) { const int p = n & 63; sc = (n & ~63) + (p >> 1) + 32 * (p & 1); }
            transpose_item(a.w_in + (size_t)l * DM * INCOLS, INCOLS, DM, 64 * kb, sc, (bf16*)(wl + WO_IN), 32 * nb, scr, F.lane, a.g_mix_pre + l * DM); continue; } r -= I_IN;
        if (r < I_OUT) { const int kb = r / 64, nb = r % 64; transpose_item(a.w_out + (size_t)l * DM * DM, DM, DM, 64 * kb, 32 * nb + j, (bf16*)(wl + WO_OUT), 32 * nb, scr, F.lane); continue; } r -= I_OUT;
        if (r < I_CQ) { const int kb = r / 16, nb = r % 16; transpose_item(a.w_cq + (size_t)l * DM * CROSSW, CROSSW, DM, 64 * kb, 32 * nb + j, (bf16*)(wl + WO_CQ), 32 * nb, scr, F.lane, a.g_x_pre + l * DM); continue; } r -= I_CQ;
        if (r < I_CKV) { const int kb = r / 32, nb = r % 32; transpose_item(a.w_ckv + (size_t)l * DM * 1024, 1024, DM, 64 * kb, 32 * nb + j, (bf16*)(ws + WS_WCKV) + (size_t)l * 1024 * DM, 32 * nb, scr, F.lane); continue; } r -= I_CKV;
        if (r < I_CO) { const int kb = r / 64, nb = r % 64; transpose_item(a.w_co + (size_t)l * CROSSW * DM, DM, CROSSW, 64 * kb, 32 * nb + j, (bf16*)(wl + WO_CO), 32 * nb, scr, F.lane); continue; } r -= I_CO;
        if (r < I_GU) { const int kb = r / 352, nb = r % 352, n = 32 * nb + j, pn = n >> 8, rr = n & 255; const float* src = (rr < 128 ? a.w_gate : a.w_up) + (size_t)l * DM * DFF;
            transpose_item(src, DFF, DM, 64 * kb, 128 * pn + (rr & 127), (bf16*)(wl + WO_GU), 32 * nb, scr, F.lane, a.g_ffn_pre + l * DM); continue; } r -= I_GU;
        { const int kb = r / 64, nb = r % 64; transpose_item(a.w_down + (size_t)l * DFF * DM, DM, DFF, 64 * kb, 32 * nb + j, (bf16*)(wl + WO_DN), 32 * nb, scr, F.lane); }
    }
}
__device__ __forceinline__ void p0_rope(Frame& F, const Args& a, unsigned char* ws) {
    float* tab = (float*)(ws + WS_ROPE);
    const int gt = (F.vcu * NWAVES + F.wave) * 64 + F.lane, NT = F.G * NWAVES * 64;
    for (int e = gt; e < M * 32; e += NT) { const int m = e >> 5, i = e & 31;
        const double ang = (double)a.pos[m] * kInvFreq[i]; const double rev = ang * 0.15915494309189535; const double fr = rev - __builtin_floor(rev);
        const float frf = (float)fr;
        tab[(size_t)e * 2] = __builtin_amdgcn_cosf(frf); tab[(size_t)e * 2 + 1] = __builtin_amdgcn_sinf(frf); }
}
__device__ __forceinline__ void p0_memn(Frame& F, const Args& a, unsigned char* ws, int ncl) {
    const int gw = F.vcu * NWAVES + F.wave, NGW = F.G * NWAVES, mpc = MM / ncl;
    for (int t = gw; t < DEPTH * MM; t += NGW) { const int l = t / MM, r = t - l * MM, c = r / mpc, rl = r - c * mpc;
        const GAS f32x4* xr = (const GAS f32x4*)(a.mem + (size_t)r * DM) + F.lane; const GAS f32x4* gr = (const GAS f32x4*)(a.g_mem + (size_t)l * DM) + F.lane;
        f32x4 v[8]; float s = 0.f;
#pragma unroll
        for (int j = 0; j < 8; ++j) { v[j] = xr[64 * j]; s += (v[j].x * v[j].x + v[j].y * v[j].y) + (v[j].z * v[j].z + v[j].w * v[j].w); }
        const float rstd = 1.f / sqrtf(wave_sum(s) * (1.f / DM) + EPS);
        const size_t drow = (size_t)c * (M / ncl) + (size_t)l * mpc + rl;
        GAS unsigned long long* o8 = (GAS unsigned long long*)((bf16*)(ws + WS_MEMN) + drow * DM) + F.lane;
#pragma unroll
        for (int j = 0; j < 8; ++j) { const f32x4 g = gr[64 * j]; o8[64 * j] = (unsigned long long)pkbf(v[j].x * rstd * g.x, v[j].y * rstd * g.y) | ((unsigned long long)pkbf(v[j].z * rstd * g.z, v[j].w * rstd * g.w) << 32); }
    }
}
template <bool FINAL>
__device__ __forceinline__ float row_update(int lane, int m, const bf16* y, const f32x4 (&gp)[8], const float* xin, const bf16* xb, bf16* xbo, float* rs, float* outf, f32x4 (&v)[8]) {
    if (xin) { const GAS f32x4* xr = (const GAS f32x4*)(xin + (size_t)m * DM) + lane;
#pragma unroll
        for (int j = 0; j < 8; ++j) v[j] = xr[64 * j];
    } else { const GAS u32x2* xr = (const GAS u32x2*)(xb + (size_t)m * DM) + lane;
#pragma unroll
        for (int j = 0; j < 8; ++j) { const u32x2 w = xr[64 * j]; v[j] = (f32x4){bflo(w.x), bfhi(w.x), bflo(w.y), bfhi(w.y)}; } }
    if (y) {
        const GAS u32x2* yr = (const GAS u32x2*)(y + (size_t)m * DM) + lane; f32x4 yv[8]; float s = 0.f;
#pragma unroll
        for (int j = 0; j < 8; ++j) { const u32x2 w = yr[64 * j]; yv[j] = (f32x4){bflo(w.x), bfhi(w.x), bflo(w.y), bfhi(w.y)}; s += (yv[j].x * yv[j].x + yv[j].y * yv[j].y) + (yv[j].z * yv[j].z + yv[j].w * yv[j].w); }
        const float rstd = 1.f / sqrtf(wave_sum(s) * (1.f / DM) + EPS);
#pragma unroll
        for (int j = 0; j < 8; ++j) v[j] = v[j] + yv[j] * rstd * gp[j];
    }
    if constexpr (FINAL) {
        GAS f32x4* xo = (GAS f32x4*)(outf + (size_t)m * DM) + lane;
#pragma unroll
        for (int j = 0; j < 8; ++j) xo[64 * j] = v[j];
        return 0.f;
    } else {
        GAS u32x2* o8 = (GAS u32x2*)(xbo + (size_t)m * DM) + lane; float s = 0.f;
#pragma unroll
        for (int j = 0; j < 8; ++j) { o8[64 * j] = (u32x2){pkbf(v[j].x, v[j].y), pkbf(v[j].z, v[j].w)}; s += (v[j].x * v[j].x + v[j].y * v[j].y) + (v[j].z * v[j].z + v[j].w * v[j].w); }
        const float rstd = 1.f / sqrtf(wave_sum(s) * (1.f / DM) + EPS);
        if (lane == 0) rs[m] = rstd;
        return rstd;
    }
}
__device__ __forceinline__ void fc_store(int lane, int m, float t, float rstd, const float* bfv, float* logf) {
    if (lane < 6) {
        const float z = t * rstd + bfv[lane];
        const float ls = fminf(z, 0.f) - log1pf(expf(-fabsf(z)));
        const int b = m / SEQ, s_ = m - b * SEQ; logf[((size_t)b * 6 + lane) * SEQ + s_] = ls; }
}
template <bool FC, bool FINAL>
__device__ __forceinline__ void row_phase(Frame& F, const bf16* y, const float* gpost, const float* xin, const bf16* xb, bf16* xbo, float* rs, float* outf,
                                          const float* wfc_src  , const float* gfc, const float* bfv, float* logf) {
    const int gw = F.rw0, NGW = F.rwstride, MEND = F.rwend;
    LAS float* wfc = (LAS float*)F.lds;
    if constexpr (FC) {
        for (int e = F.tid; e < 6 * DM; e += NWAVES * 64) { const int k = e / 6, jj = e - 6 * k; wfc[jj * DM + k] = wfc_src[(size_t)k * INCOLS + NPROJ + jj] * gfc[k]; }
        __syncthreads();
    }
    f32x4 gp[8];
#pragma unroll
    for (int j = 0; j < 8; ++j) gp[j] = y ? ((const GAS f32x4*)gpost)[F.lane + 64 * j] : (f32x4){0.f, 0.f, 0.f, 0.f};
    if constexpr (FC) {
        for (int m = gw; m < MEND; m += 2 * NGW) {
            const int m1 = m + NGW; f32x4 v0[8], v1[8];
            const float r0 = row_update<false>(F.lane, m, y, gp, xin, xb, xbo, rs, outf, v0);
            const bool two = m1 < MEND; float r1 = 0.f;
#pragma unroll
            for (int j = 0; j < 8; ++j) v1[j] = (f32x4){0.f, 0.f, 0.f, 0.f};
            if (two) r1 = row_update<false>(F.lane, m1, y, gp, xin, xb, xbo, rs, outf, v1);
            float ta = 0.f, tb = 0.f;
#pragma unroll
            for (int jj = 0; jj < 6; ++jj) { float a0 = 0.f, a1 = 0.f;
#pragma unroll
                for (int j = 0; j < 8; ++j) { const f32x4 w = *(const LAS f32x4*)(wfc + jj * DM + 4 * F.lane + 256 * j);
                    a0 += (v0[j].x * w.x + v0[j].y * w.y) + (v0[j].z * w.z + v0[j].w * w.w); a1 += (v1[j].x * w.x + v1[j].y * w.y) + (v1[j].z * w.z + v1[j].w * w.w); }
                const float sa = wave_sum(a0), sb = wave_sum(a1); ta = (F.lane == jj) ? sa : ta; tb = (F.lane == jj) ? sb : tb; }
            fc_store(F.lane, m, ta, r0, bfv, logf);
            if (two) fc_store(F.lane, m1, tb, r1, bfv, logf);
        }
        __syncthreads();
    } else {
        for (int m = gw; m < MEND; m += NGW) { f32x4 v[8]; (void)row_update<FINAL>(F.lane, m, y, gp, xin, xb, xbo, rs, outf, v); }
    }
}
__device__ __forceinline__ void subnorm_phase(Frame& F, const Args& a, int l, const bf16* OA, bf16* HB) {
    const int gw = F.rw0, NGW = F.rwstride, MEND = F.rwend, lane = F.lane;
    const float d1 = wave_sum(a.lam_q1[l * 64 + lane] * a.lam_k1[l * 64 + lane]), d2 = wave_sum(a.lam_q2[l * 64 + lane] * a.lam_k2[l * 64 + lane]);
    const float lam_init = 0.8f - 0.6f * expf(-0.3f * (float)l);
    const float lam = (expf(d1) - expf(d2)) + lam_init, post = 1.0f - lam_init;
    const int hd = lane >> 4, c8 = (lane & 15) * 8;
    f32x4 gd0 = *(const GAS f32x4*)(a.g_diff_sub + l * 128 + c8), gd1 = *(const GAS f32x4*)(a.g_diff_sub + l * 128 + c8 + 4);
    f32x4 gs[3], gf[3];
#pragma unroll
    for (int j = 0; j < 3; ++j) { gs[j] = *(const GAS f32x4*)(a.g_sb_out + l * 768 + 4 * lane + 256 * j); gf[j] = *(const GAS f32x4*)(a.g_fox_out + l * 768 + 4 * lane + 256 * j); }
    for (int m = gw; m < MEND; m += NGW) {
        const v4u w1 = *(const GAS v4u*)(OA + (size_t)m * 1024 + hd * 256 + c8), w2 = *(const GAS v4u*)(OA + (size_t)m * 1024 + hd * 256 + 128 + c8);
        bf16* hr = HB + (size_t)m * DM;
        u32x2 sb[3], fx[3];
#pragma unroll
        for (int j = 0; j < 3; ++j) { sb[j] = *(const GAS u32x2*)(hr + 512 + 4 * lane + 256 * j); fx[j] = *(const GAS u32x2*)(hr + 1280 + 4 * lane + 256 * j); }
        float d[8];
        d[0] = bflo(w1.x) - lam * bflo(w2.x); d[1] = bfhi(w1.x) - lam * bfhi(w2.x); d[2] = bflo(w1.y) - lam * bflo(w2.y); d[3] = bfhi(w1.y) - lam * bfhi(w2.y);
        d[4] = bflo(w1.z) - lam * bflo(w2.z); d[5] = bfhi(w1.z) - lam * bfhi(w2.z); d[6] = bflo(w1.w) - lam * bflo(w2.w); d[7] = bfhi(w1.w) - lam * bfhi(w2.w);
        float s = 0.f;
#pragma unroll
        for (int k = 0; k < 8; ++k) s += d[k] * d[k];
        s += __shfl_xor(s, 1); s += __shfl_xor(s, 2); s += __shfl_xor(s, 4); s += __shfl_xor(s, 8);
        const float rd = post / sqrtf(s * (1.f / 128.f) + EPS);
        v4u od; od.x = pkbf(d[0] * rd * gd0.x, d[1] * rd * gd0.y); od.y = pkbf(d[2] * rd * gd0.z, d[3] * rd * gd0.w); od.z = pkbf(d[4] * rd * gd1.x, d[5] * rd * gd1.y); od.w = pkbf(d[6] * rd * gd1.z, d[7] * rd * gd1.w);
        *(GAS v4u*)(hr + hd * 128 + c8) = od;
        float ss = 0.f, sf = 0.f; f32x4 vs[3], vf[3];
#pragma unroll
        for (int j = 0; j < 3; ++j) { vs[j] = (f32x4){bflo(sb[j].x), bfhi(sb[j].x), bflo(sb[j].y), bfhi(sb[j].y)}; vf[j] = (f32x4){bflo(fx[j].x), bfhi(fx[j].x), bflo(fx[j].y), bfhi(fx[j].y)};
            ss += (vs[j].x * vs[j].x + vs[j].y * vs[j].y) + (vs[j].z * vs[j].z + vs[j].w * vs[j].w); sf += (vf[j].x * vf[j].x + vf[j].y * vf[j].y) + (vf[j].z * vf[j].z + vf[j].w * vf[j].w); }
        const float rs = 1.f / sqrtf(wave_sum(ss) * (1.f / 768.f) + EPS), rf = 1.f / sqrtf(wave_sum(sf) * (1.f / 768.f) + EPS);
#pragma unroll
        for (int j = 0; j < 3; ++j) { const f32x4 u = vs[j] * rs * gs[j], w = vf[j] * rf * gf[j];
            *(GAS u32x2*)(hr + 512 + 4 * lane + 256 * j) = (u32x2){pkbf(u.x, u.y), pkbf(u.z, u.w)}; *(GAS u32x2*)(hr + 1280 + 4 * lane + 256 * j) = (u32x2){pkbf(w.x, w.y), pkbf(w.z, w.w)}; }
    }
}
__device__ __forceinline__ unsigned claim_issue(Frame& F, gu32* ctr) {
    unsigned v = 0u;
    if (F.tid == 0) v = __hip_atomic_fetch_add(ctr, 1u, __ATOMIC_RELAXED, __HIP_MEMORY_SCOPE_AGENT);
    return v;
}
__device__ __forceinline__ int claim_publish(Frame& F, unsigned v) {
    LAS unsigned* slot = (LAS unsigned*)(F.lds + att::OFF_MISC);
    if (F.tid == 0) *slot = v;
    __syncthreads();
    const int r = (int)*slot;
    __syncthreads();
    return r;
}
__global__ void __launch_bounds__(NWAVES * 64, 2) trunk_fwd(Args args) {
    extern __shared__ __attribute__((aligned(16))) unsigned char lds[];
    Frame F;
    F.lds = (LAS unsigned char*)lds;
    F.tid = threadIdx.x; F.lane = F.tid & 63; F.wave = __builtin_amdgcn_readfirstlane(F.tid >> 6);
    F.G = gridDim.x; { const int bx = blockIdx.x; F.vcu = (F.G % 8 == 0) ? (bx % 8) * (F.G / 8) + bx / 8 : bx; }
    unsigned char* ws = args.ws;
#if CODE_PREFETCH
    { const unsigned long long pc_ = (unsigned long long)__builtin_amdgcn_s_getpc();
      const unsigned char* cb_ = (const unsigned char*)((pc_ & ~255ull) - 1024ull);
      const unsigned off_ = (((unsigned)blockIdx.x >> 3) * (NWAVES * 64) + (unsigned)threadIdx.x) * 16u;
      if (off_ < CODE_PREFETCH_BYTES) { const v4u c_ = *(const GAS v4u*)(cb_ + off_); asm volatile("" :: "v"(c_)); } }
#endif
    gu32* ctl = (gu32*)(ws + WS_CTL);
    volatile LAS unsigned* MISC = (volatile LAS unsigned*)(F.lds + MISC_OFF);
    for (int u = F.tid; u < (LDS_BYTES - LDSCTL_OFF) / 4; u += NWAVES * 64) ((LAS unsigned*)(F.lds + LDSCTL_OFF))[u] = 0u;
    __syncthreads();
    const int ncl = (CLASS_PIPE && F.G % 8 == 0) ? 8 : 1, xc = (ncl == 8) ? ((int)blockIdx.x & 7) : 0, rk = (ncl == 8) ? ((int)blockIdx.x >> 3) : (int)blockIdx.x, NC = F.G / ncl;
    const int crows = M / ncl, crow0 = xc * crows, bpc = BATCH / ncl, mpc = MM / ncl;
    XcdBarrier bar; bar.bar = (unsigned*)(ctl + CW_BAR); bar.x = 0; bar.st = nullptr; bar.npart = 0u;
    XcdBarrier cbar = bar;
    const int lo = args.ph_lo, hi = args.ph_hi;
    if (hi - lo > 1) { bar = xcd_barrier_post((unsigned*)(ctl + CW_BAR), MISC + 8);
        cbar = (ncl == 8) ? xcd_barrier_post((unsigned*)(ctl + CW_BAR) + (1 + xc) * XCD_BAR_WORDS, MISC + 10, (unsigned)NC) : bar; }
#define SET_ROWS_GLOBAL() do { F.rw0 = F.vcu * NWAVES + F.wave; F.rwend = M; F.rwstride = F.G * NWAVES; } while (0)
#define SET_ROWS_CLASS()  do { F.rw0 = crow0 + rk * NWAVES + F.wave; F.rwend = crow0 + crows; F.rwstride = NC * NWAVES; } while (0)
#define CLASS_BAR() xcd_barrier(cbar)
#define GRID_BAR() xcd_barrier(bar)
#define IN(k) (lo <= (k) && (k) < hi)
#define BOTH(k) (IN(k) && IN((k) + 1))
#define ALDS ((__attribute__((address_space(3))) char*)F.lds)
    bf16* XB = (bf16*)(ws + WS_XB); bf16* YB = (bf16*)(ws + WS_YB); bf16* PROJ = (bf16*)(ws + WS_BIG); float* RS = (float*)(ws + WS_RS);
    float* LOGF = (float*)(ws + WS_LOGF); const float* ROPE = (const float*)(ws + WS_ROPE);
    bf16* XBc = XB + (size_t)crow0 * DM; bf16* YBc = YB + (size_t)crow0 * DM; bf16* PROJc = PROJ + (size_t)crow0 * NPROJ; float* RSc = RS + crow0; const float* ROPEc = ROPE + (size_t)crow0 * 64;
    bf16* BIGc = PROJc;
    bf16* HIDc = BIGc; bf16* QXc = BIGc; bf16* O2c = BIGc + (size_t)crows * CROSSW;
    bf16* QXv = QXc - (size_t)crow0 * CROSSW; bf16* O2v = O2c - (size_t)crow0 * CROSSW;
    bf16* HBc = (bf16*)((unsigned char*)args.out + (size_t)crow0 * DM * 4); bf16* OAc = HBc + (size_t)crows * DM;
    bf16* HBv = HBc - (size_t)crow0 * DM; bf16* OAv = OAc - (size_t)crow0 * 1024;
    const bf16* MEMNc = (const bf16*)(ws + WS_MEMN) + (size_t)crow0 * DM;
    bf16* KVc = (bf16*)(ws + WS_KV) + (size_t)xc * DEPTH * mpc * 1024;

    if (EN(0) && IN(0)) { PHASE_FENCE(F);
        p0_weights(F, args, ws);
        p0_rope(F, args, ws);
        p0_memn(F, args, ws, ncl);
        __syncthreads();
        SET_ROWS_GLOBAL();
        row_phase<true, false>(F, nullptr, nullptr, args.x, XB, XB, RS, nullptr, args.w_in, args.g_mix_pre, args.b_f, LOGF);
        if (BOTH(0)) GRID_BAR();
    }
    SET_ROWS_CLASS();
#if defined(DEPHASE_US)
    if (hi - lo > 1) { if (F.tid == 0) { const unsigned long long t0 = __builtin_amdgcn_s_memrealtime(); while (__builtin_amdgcn_s_memrealtime() - t0 < (unsigned long long)(xc * DEPHASE_US * 100)) __builtin_amdgcn_s_sleep(8); } __syncthreads(); }
#endif
    for (int l = 0; l < DEPTH; ++l) {
        const int pb = 1 + 12 * l;
        unsigned char* wl = ws + WS_W + (size_t)l * W_LAYER;
        if (EN(1) && IN(pb + 0)) { PHASE_FENCE(F);
            if (EN_G0 && l == 0) { pg8::Gemm g{MEMNc, (const bf16*)(ws + WS_WCKV), DEPTH * mpc, DEPTH * 1024, DM}; pg8::KvOrder S{mpc / 256, NC, rk};
                pg8::EpiStore E{KVc, 1024, nullptr, 0, 3, nullptr}; pg8::gemm_phase<pg8::EpiStore, pg8::KvOrder, GEMM_ALIGN, GEMM_SP2>(F.lds, g, S, E); }
            pg8::Gemm g{XBc, (const bf16*)(wl + WO_IN), crows, NPROJ, DM}; pg8::ClassOrder S; S.init(crows, NPROJ, NC, rk);
            pg8::EpiStore E{PROJc, NPROJ, ROPEc, ROPE_TILES, -1, RSc}; pg8::gemm_phase<pg8::EpiStore, pg8::ClassOrder, GEMM_ALIGN, GEMM_SP2>(F.lds, g, S, E);
            if (BOTH(pb + 0)) CLASS_BAR();
        }
        if (EN(2) && IN(pb + 1)) { PHASE_FENCE(F);
            const int nbh = bpc * 6, nbv = bpc * 8;
            gu32* q0 = ctl + CW_Q + 64 * ((3 * l) * 8 + xc);
            { gu32* qc_ = q0; unsigned pend_ = claim_issue(F, qc_); for (int u = claim_publish(F, pend_); u < 8 * nbh; u = claim_publish(F, pend_)) { pend_ = claim_issue(F, qc_); const int qb = 7 - u / nbh, bh = xc * nbh + u % nbh, b = bh / 6, h = bh % 6;
                const size_t r0 = (size_t)b * SEQ; const int pos0 = qb * 256;
                att::attn_unit<1>(PROJ + (r0 + pos0) * NPROJ + QB_C + h * 128, NPROJ, PROJ + r0 * NPROJ + KB_C + h * 128, PROJ + r0 * NPROJ + VB_C + h * 128, NPROJ,
                                  HBv + (r0 + pos0) * DM + 512 + h * 128, DM, pos0, 4 * (qb + 1), 0, nullptr, ALDS); } }
            { gu32* qc_ = q0 + 64 * 8; unsigned pend_ = claim_issue(F, qc_); for (int u = claim_publish(F, pend_); u < 8 * nbh; u = claim_publish(F, pend_)) { pend_ = claim_issue(F, qc_); const int qb = 7 - u / nbh, bh = xc * nbh + u % nbh, b = bh / 6, h = bh % 6;
                const size_t r0 = (size_t)b * SEQ; const int pos0 = qb * 256;
                att::ATTN_SM<2>(PROJ + (r0 + pos0) * NPROJ + QC_C + h * 128, NPROJ, PROJ + r0 * NPROJ + KC_C + h * 128, PROJ + r0 * NPROJ + VC_C + h * 128, NPROJ,
                                  HBv + (r0 + pos0) * DM + 1280 + h * 128, DM, pos0, 4 * (qb + 1), 0, LOGF + (size_t)bh * SEQ, ALDS); } }
            { gu32* qc_ = q0 + 64 * 16; unsigned pend_ = claim_issue(F, qc_); for (int u = claim_publish(F, pend_); u < 8 * nbv; u = claim_publish(F, pend_)) { pend_ = claim_issue(F, qc_); const int qb = 7 - u / nbv, bv = xc * nbv + u % nbv, b = bv / 8, vh = bv % 8, h = vh >> 1, jm = vh & 1;
                const size_t r0 = (size_t)b * SEQ; const int pos0 = qb * 256;
                att::ATTN_SM<0>(PROJ + (r0 + pos0) * NPROJ + QA_C + h * 128 + jm * 64, NPROJ, PROJ + r0 * NPROJ + KA_C + h * 128, PROJ + r0 * NPROJ + VA_C + h * 128, NPROJ,
                                  OAv + (r0 + pos0) * 1024 + vh * 128, 1024, pos0, 4 * (qb + 1), jm * 128, nullptr, ALDS); } }
            if (BOTH(pb + 1)) CLASS_BAR();
        }
        if (EN(3) && IN(pb + 2)) { PHASE_FENCE(F); subnorm_phase(F, args, l, OAv, HBv); if (BOTH(pb + 2)) CLASS_BAR(); }
        if (EN(4) && IN(pb + 3)) { PHASE_FENCE(F);
            pg8::Gemm g{HBc, (const bf16*)(wl + WO_OUT), crows, DM, DM}; pg8::ClassOrder S; S.init(crows, DM, NC, rk);
            pg8::EpiStore E{YBc, DM, nullptr, 0, -1, nullptr}; pg8::gemm_phase<pg8::EpiStore, pg8::ClassOrder, GEMM_ALIGN, GEMM_SP2>(F.lds, g, S, E);
            if (BOTH(pb + 3)) CLASS_BAR();
        }
        if (EN(5) && IN(pb + 4)) { PHASE_FENCE(F);
            row_phase<false, false>(F, YB, args.g_mix_post + l * DM, nullptr, XB, XB, RS, nullptr, nullptr, nullptr, nullptr, nullptr); if (BOTH(pb + 4)) CLASS_BAR(); }
        if (EN(6) && IN(pb + 5)) { PHASE_FENCE(F);
            pg8::Gemm g{XBc, (const bf16*)(wl + WO_CQ), crows, CROSSW, DM}; pg8::ClassOrder S; S.init(crows, CROSSW, NC, rk);
            pg8::EpiStore E{QXc, CROSSW, nullptr, 0, -1, RSc}; pg8::gemm_phase<pg8::EpiStore, pg8::ClassOrder, GEMM_ALIGN, GEMM_SP2>(F.lds, g, S, E);
            if (BOTH(pb + 5)) CLASS_BAR();
        }
        if (EN(7) && IN(pb + 6)) { PHASE_FENCE(F);
            const bf16* kvl = KVc + (size_t)l * mpc * 1024;
            for (int u = rk; u < bpc * 4 * 8; u += NC) { const int qb = u & 7, bh = u >> 3, lb = bh >> 2, h = bh & 3; const size_t r0 = (size_t)(xc * bpc + lb) * SEQ + qb * 256;
                att::ATTN_SM<3>(QXv + r0 * CROSSW + h * 128, CROSSW, kvl + (size_t)lb * MEMLEN * 1024 + h * 128, kvl + (size_t)lb * MEMLEN * 1024 + 512 + h * 128, 1024,
                                  O2v + r0 * CROSSW + h * 128, CROSSW, 0, 4, 0, nullptr, ALDS); }
            if (BOTH(pb + 6)) CLASS_BAR();
        }
        if (EN(8) && IN(pb + 7)) { PHASE_FENCE(F);
            pg8::Gemm g{O2c, (const bf16*)(wl + WO_CO), crows, DM, CROSSW}; pg8::ClassOrder S; S.init(crows, DM, NC, rk);
            pg8::EpiStore E{YBc, DM, nullptr, 0, -1, nullptr}; pg8::gemm_phase<pg8::EpiStore, pg8::ClassOrder, GEMM_ALIGN, GEMM_SP2>(F.lds, g, S, E);
            if (BOTH(pb + 7)) CLASS_BAR();
        }
        if (EN(9) && IN(pb + 8)) { PHASE_FENCE(F);
            row_phase<false, false>(F, YB, args.g_x_post + l * DM, nullptr, XB, XB, RS, nullptr, nullptr, nullptr, nullptr, nullptr); if (BOTH(pb + 8)) CLASS_BAR(); }
        if (EN(10) && IN(pb + 9)) { PHASE_FENCE(F);
            pg8::Gemm g{XBc, (const bf16*)(wl + WO_GU), crows, 2 * DFF, DM}; pg8::ClassOrder S; S.init(crows, 2 * DFF, NC, rk);
            pg8::EpiSwiGLU E{HIDc, DFF, RSc}; pg8::gemm_phase<pg8::EpiSwiGLU, pg8::ClassOrder, GEMM_ALIGN, GEMM_SP2>(F.lds, g, S, E);
            if (BOTH(pb + 9)) CLASS_BAR();
        }
        if (EN(11) && IN(pb + 10)) { PHASE_FENCE(F);
            pg8::Gemm g{HIDc, (const bf16*)(wl + WO_DN), crows, DM, DFF}; pg8::ClassOrder S; S.init(crows, DM, NC, rk);
            pg8::EpiStore E{YBc, DM, nullptr, 0, -1, nullptr}; pg8::gemm_phase<pg8::EpiStore, pg8::ClassOrder, GEMM_ALIGN, GEMM_SP2>(F.lds, g, S, E);
            if (BOTH(pb + 10)) CLASS_BAR();
        }
        if (EN(12) && IN(pb + 11)) { PHASE_FENCE(F);
            if (l + 1 < DEPTH) row_phase<true, false>(F, YB, args.g_ffn_post + l * DM, nullptr, XB, XB, RS, nullptr, args.w_in + (size_t)(l + 1) * DM * INCOLS, args.g_mix_pre + (l + 1) * DM, args.b_f + (l + 1) * 6, LOGF);
            else row_phase<false, true>(F, YB, args.g_ffn_post + l * DM, nullptr, XB, XB, nullptr, args.out, nullptr, nullptr, nullptr, nullptr);
            if (BOTH(pb + 11)) CLASS_BAR();
        }
    }
#undef IN
#undef BOTH
#undef GRID_BAR
#undef CLASS_BAR
#undef SET_ROWS_GLOBAL
#undef SET_ROWS_CLASS
#undef ALDS
}

extern "C" void kernel_launch(void* const* d_in, const int* in_sizes, int n_in, void* d_out, int out_size, void* d_ws, size_t ws_size, hipStream_t stream) {
    static int grid = 0;
    if (grid == 0) {
        if (n_in != 26 || in_sizes[0] != M * DM || out_size != M * DM || ws_size < WS_END) { fprintf(stderr, "kernel_launch: unexpected shapes (n_in %d, in0 %d, out %d, ws %zu)\n", n_in, n_in > 0 ? in_sizes[0] : -1, out_size, ws_size); grid = -1; return; }
        int dev = 0, cus = 0, per_cu = 0;
        if (hipGetDevice(&dev) != hipSuccess || hipDeviceGetAttribute(&cus, hipDeviceAttributeMultiprocessorCount, dev) != hipSuccess) { grid = -1; return; }
        if (hipFuncSetAttribute((const void*)trunk_fwd, hipFuncAttributeMaxDynamicSharedMemorySize, LDS_BYTES) != hipSuccess) { fprintf(stderr, "kernel_launch: hipFuncSetAttribute failed\n"); grid = -1; return; }
        if (hipOccupancyMaxActiveBlocksPerMultiprocessor(&per_cu, (const void*)trunk_fwd, NWAVES * 64, LDS_BYTES) != hipSuccess || per_cu < 1) fprintf(stderr, "kernel_launch: occupancy query reports %d\n", per_cu);
        (void)hipGetLastError();
        grid = cus;
    }
    if (grid < 0) return;
    if (hipMemsetAsync((char*)d_ws + WS_CTL, 0, CTL_ZERO_BYTES, stream) != hipSuccess) return;
    Args a{};
    a.x = (const float*)d_in[0]; a.mem = (const float*)d_in[1]; a.pos = (const int*)d_in[2];
    a.g_mix_pre = (const float*)d_in[3]; a.g_mix_post = (const float*)d_in[4]; a.w_in = (const float*)d_in[5]; a.b_f = (const float*)d_in[6];
    a.lam_q1 = (const float*)d_in[7]; a.lam_k1 = (const float*)d_in[8]; a.lam_q2 = (const float*)d_in[9]; a.lam_k2 = (const float*)d_in[10];
    a.g_diff_sub = (const float*)d_in[11]; a.g_sb_out = (const float*)d_in[12]; a.g_fox_out = (const float*)d_in[13]; a.w_out = (const float*)d_in[14];
    a.g_x_pre = (const float*)d_in[15]; a.g_x_post = (const float*)d_in[16]; a.g_mem = (const float*)d_in[17]; a.w_cq = (const float*)d_in[18]; a.w_ckv = (const float*)d_in[19]; a.w_co = (const float*)d_in[20];
    a.g_ffn_pre = (const float*)d_in[21]; a.g_ffn_post = (const float*)d_in[22]; a.w_gate = (const float*)d_in[23]; a.w_up = (const float*)d_in[24]; a.w_down = (const float*)d_in[25];
    a.out = (float*)d_out; a.ws = (unsigned char*)d_ws;
#if MK_ONE_LAUNCH
#if defined(PROBE_PRE_HI)
    a.ph_lo = 0; a.ph_hi = PROBE_PRE_HI; a.li = 1;
    hipLaunchKernelGGL(trunk_fwd, dim3(grid), dim3(NWAVES * 64), LDS_BYTES, stream, a); (void)hipMemsetAsync((char*)d_ws + WS_CTL, 0, CTL_ZERO_BYTES, stream);
#endif
    a.ph_lo = 0; a.ph_hi = N_PHASES; a.li = 0;
    hipLaunchKernelGGL(trunk_fwd, dim3(grid), dim3(NWAVES * 64), LDS_BYTES, stream, a);
#if defined(PROBE_POST_HI)
    (void)hipMemsetAsync((char*)d_ws + WS_CTL, 0, CTL_ZERO_BYTES, stream); a.ph_lo = 0; a.ph_hi = PROBE_POST_HI; a.li = 1;
    hipLaunchKernelGGL(trunk_fwd, dim3(grid), dim3(NWAVES * 64), LDS_BYTES, stream, a);
#endif
#if defined(PROBE_PRE_HI)
#endif
#else
    for (int p = 0; p < N_PHASES; ++p) { a.ph_lo = p; a.ph_hi = p + 1; a.li = p;
        hipLaunchKernelGGL(trunk_fwd, dim3(grid), dim3(NWAVES * 64), LDS_BYTES, stream, a); }
#endif
}
```

```cpp
#include <hip/hip_runtime.h>
#include <hip/hip_bf16.h>
#include <cstdio>
#include <cstdint>
#include <cmath>
#define MK_ONE_LAUNCH 1
namespace pg8 {
#define PG8_LAS __attribute__((address_space(3)))
typedef unsigned short bf16_t;
typedef short bf16x8 __attribute__((ext_vector_type(8)));
typedef float f32x4 __attribute__((ext_vector_type(4)));
typedef unsigned u32x4 __attribute__((ext_vector_type(4)));
constexpr int BM = 256, BK = 64, HALF = 128, HTB = HALF * BK * 2  , STAGE_BYTES = 8 * HTB, NXCD = 8, WGM = 8;

__host__ __device__ __forceinline__ int lds_byte(int r, int c) { const int st = (r >> 4) * 2 + (c >> 5), rr = r & 15, cc = c & 31, ob = rr * 64 + cc * 2; return st * 1024 + (ob ^ (((ob >> 9) & 1) << 5)); }
__host__ __device__ __forceinline__ void stage_rc(int b, int& R, int& C) { const int st = b / 1024, sb = b % 1024, swz = sb ^ (((sb >> 9) & 1) << 5); R = (st >> 1) * 16 + swz / 64; C = (st & 1) * 32 + (swz % 64) / 2; }
__host__ __device__ __forceinline__ int perm32(int rho) { const int n = rho >> 4, i = rho & 15; return 8 * (i >> 2) + 4 * n + (i & 3); }

struct Unit { int pm, pn; };
struct Gemm { const bf16_t* A; const bf16_t* Bt; int M, N, K; };

struct StaticOrder {
    int nM, nN, nwg, G, c;
    __host__ __device__ void init(int M, int N, int G_, int c_) { nM = M / BM; nN = N / BM; nwg = nM * nN; G = G_; c = c_; }
    __host__ __device__ bool next(int i, Unit& u) const {
        const long L = (long)i * G + c; if (L >= nwg) return false;
        int wgid = (int)L; { const int q = nwg / NXCD, r = nwg % NXCD, xcd = wgid % NXCD, off = wgid / NXCD; wgid = (xcd < r ? xcd * (q + 1) : r * (q + 1) + (xcd - r) * q) + off; }
        const int nig = WGM * nN, gid = wgid / nig, fm = gid * WGM, gsz = (nM - fm) < WGM ? (nM - fm) : WGM;
        u.pm = fm + ((wgid % nig) % gsz); u.pn = (wgid % nig) / gsz; return true;
    }
    __device__ __forceinline__ void a_ready(const Unit&) const {}
    __device__ __forceinline__ void done(const Unit&) const {}
};

__device__ __forceinline__ unsigned cvt_pk_bf16(float lo, float hi) { unsigned r; asm volatile("v_cvt_pk_bf16_f32 %0, %1, %2" : "=v"(r) : "v"(lo), "v"(hi)); return r; }
typedef float f32x2 __attribute__((ext_vector_type(2)));
struct EpiStore {
    static constexpr bool PERM = true, AFTER_DRAIN = false;
    bf16_t* O; int ldc; const float* rope; int rope_tiles; int pn_mask;
    const float* rs;
    __device__ __forceinline__ void prefetch(const Unit& u, int wr, int fr, float (&epre)[8]) const {
        const int row0 = u.pm * BM + wr * 64 + fr;
#pragma unroll
        for (int i = 0; i < 8; ++i) epre[i] = rs ? rs[row0 + (i >> 2) * HALF + (i & 3) * 16] : 1.0f;
    }
    __device__ __forceinline__ void operator()(const f32x4 (&acc)[2][2][4][2], const Unit& u, int wr, int wc, int fr, int fq, const float (&epre)[8]) const {
        const int row0 = u.pm * BM + wr * 64 + fr; const int col0 = (u.pn & pn_mask) * BM + wc * 32 + 8 * fq;
        const bool do_rope = u.pn < rope_tiles;
#pragma unroll
        for (int ai = 0; ai < 2; ++ai)
#pragma unroll
            for (int m = 0; m < 4; ++m) { const int row = row0 + ai * HALF + m * 16; bf16_t* rowp = O + (size_t)row * ldc + col0;
                f32x4 cs0 = {1.f, 0.f, 1.f, 0.f}, cs1 = {1.f, 0.f, 1.f, 0.f}; const float rsc = epre[ai * 4 + m];
                if (do_rope) { const float* rp = rope + (size_t)row * 64 + (16 * (wc & 1) + 4 * fq) * 2; cs0 = *(const f32x4*)rp; cs1 = *(const f32x4*)(rp + 4); }
#pragma unroll
                for (int bj = 0; bj < 2; ++bj) { f32x4 v0 = acc[ai][bj][m][0] * rsc, v1 = acc[ai][bj][m][1] * rsc;
                    if (do_rope) {
                        f32x4 r0, r1;
                        r0[0] = v0[0] * cs0[0] - v0[1] * cs0[1]; r0[1] = v0[1] * cs0[0] + v0[0] * cs0[1];
                        r0[2] = v0[2] * cs0[2] - v0[3] * cs0[3]; r0[3] = v0[3] * cs0[2] + v0[2] * cs0[3];
                        r1[0] = v1[0] * cs1[0] - v1[1] * cs1[1]; r1[1] = v1[1] * cs1[0] + v1[0] * cs1[1];
                        r1[2] = v1[2] * cs1[2] - v1[3] * cs1[3]; r1[3] = v1[3] * cs1[2] + v1[2] * cs1[3];
                        v0 = r0; v1 = r1; }
                    u32x4 w; w.x = cvt_pk_bf16(v0[0], v0[1]); w.y = cvt_pk_bf16(v0[2], v0[3]); w.z = cvt_pk_bf16(v1[0], v1[1]); w.w = cvt_pk_bf16(v1[2], v1[3]);
                    *(u32x4*)(rowp + bj * HALF) = w; } }
    }
};
struct EpiSwiGLU {
    static constexpr bool PERM = true, AFTER_DRAIN = false;
    bf16_t* O; int ldc; const float* rs;
    __device__ __forceinline__ static float sw(float g, float up) { const float e = __builtin_amdgcn_exp2f(-1.4426950408889634f * g); return g * up * __builtin_amdgcn_rcpf(1.0f + e); }
    __device__ __forceinline__ void prefetch(const Unit& u, int wr, int fr, float (&epre)[8]) const {
        const int row0 = u.pm * BM + wr * 64 + fr;
#pragma unroll
        for (int i = 0; i < 8; ++i) epre[i] = rs[row0 + (i >> 2) * HALF + (i & 3) * 16];
    }
    __device__ __forceinline__ void operator()(const f32x4 (&acc)[2][2][4][2], const Unit& u, int wr, int wc, int fr, int fq, const float (&epre)[8]) const {
        const int row0 = u.pm * BM + wr * 64 + fr; const int col0 = u.pn * HALF + wc * 32 + 8 * fq;
#pragma unroll
        for (int ai = 0; ai < 2; ++ai)
#pragma unroll
            for (int m = 0; m < 4; ++m) { const int row = row0 + ai * HALF + m * 16; bf16_t* rowp = O + (size_t)row * ldc + col0;
                const float rsc = epre[ai * 4 + m];
                const f32x4 g0 = acc[ai][0][m][0] * rsc, g1 = acc[ai][0][m][1] * rsc, u0 = acc[ai][1][m][0] * rsc, u1 = acc[ai][1][m][1] * rsc;
                u32x4 w; w.x = cvt_pk_bf16(sw(g0[0], u0[0]), sw(g0[1], u0[1])); w.y = cvt_pk_bf16(sw(g0[2], u0[2]), sw(g0[3], u0[3]));
                w.z = cvt_pk_bf16(sw(g1[0], u1[0]), sw(g1[1], u1[1])); w.w = cvt_pk_bf16(sw(g1[2], u1[2]), sw(g1[3], u1[3]));
                *(u32x4*)rowp = w; }
    }
};
struct ClassOrder {
    int nM, nN, NC, rk;
    __host__ __device__ void init(int M, int N, int NC_, int rk_) { nM = M / BM; nN = N / BM; NC = NC_; rk = rk_; }
    __host__ __device__ bool next(int i, Unit& u) const { const int L = i * NC + rk; if (L >= nM * nN) return false;
        const int per = 8 * nN, g = L / per, r = L - g * per, gs = (nM - 8 * g) < 8 ? (nM - 8 * g) : 8; u.pm = 8 * g + r % gs; u.pn = r / gs; return true; }
    __device__ __forceinline__ void a_ready(const Unit&) const {}
    __device__ __forceinline__ void done(const Unit&) const {}
};
struct KvOrder {
    int T, NC, rk;
    __host__ __device__ bool next(int i, Unit& u) const { const int per = 4 * T, L = i * NC + rk; if (L >= 4 * per) return false; const int l = L / per, r = L - l * per;
        u.pm = l * T + (r >> 2); u.pn = 4 * l + (r & 3); return true; }
    __device__ __forceinline__ void a_ready(const Unit&) const {}
    __device__ __forceinline__ void done(const Unit&) const {}
};
#ifndef GEMM_DMA_IN_MMA
#define GEMM_DMA_IN_MMA 0
#endif
#ifndef GEMM_XMFMA
#define GEMM_XMFMA 0
#endif
template <class Epi, class Sched, bool ALIGN_EPI = false, bool SP2 = false>
__device__ __forceinline__ void gemm_phase(PG8_LAS unsigned char* lds, const Gemm g, const Sched& S, const Epi& E) {
    int tid_ = threadIdx.x; asm volatile("" : "+v"(tid_));
    const int tid = tid_, wid = __builtin_amdgcn_readfirstlane(tid >> 6), lane = tid & 63, wr = wid >> 2, wc = wid & 3, fr = lane & 15, fq = lane >> 4;
    constexpr bool DMA_IN_MMA = SP2 && (GEMM_DMA_IN_MMA != 0);
    const int K = g.K, nt = K / BK;
    unsigned voffA[2], voffB[2];
#pragma unroll
    for (int i = 0; i < 2; ++i) { int R, C; stage_rc(tid * 16 + i * 8192, R, C); const int Rb = Epi::PERM ? ((R & ~31) + perm32(R & 31)) : R;
        voffA[i] = (unsigned)(R * K + C) * 2u; voffB[i] = (unsigned)(Rb * K + C) * 2u; }
    const size_t kstep = (size_t)(BK * 2);
    const size_t hstep = (size_t)HALF * K * 2;
    const size_t tstep = 2 * hstep;
    const unsigned ldsw = (unsigned)wid * 1024u;
    const int aoff = lds_byte(wr * 64 + fr, fq * 8), boff = lds_byte(wc * 32 + fr, fq * 8);
#define PG8_SA(b, h) (((b) * 2 + (h)) * HTB)
#define PG8_SB(b, h) ((4 + (b) * 2 + (h)) * HTB)
#define PG8_STAGE(bufoff, gbase, voff) do { _Pragma("unroll") for (int _i = 0; _i < 2; ++_i) \
        __builtin_amdgcn_global_load_lds((const unsigned*)((const char*)(gbase) + (voff)[_i]), (PG8_LAS unsigned*)(lds + (bufoff) + ldsw + _i * 8192), 16, 0, 0); } while (0)
#define PG8_LDA(dst, b, h) do { _Pragma("unroll") for (int m = 0; m < 4; ++m) _Pragma("unroll") for (int k = 0; k < 2; ++k) dst[m][k] = *(const PG8_LAS bf16x8*)(lds + PG8_SA(b, h) + aoff + m * 2048 + k * 1024); } while (0)
#define PG8_LDB(dst, b, h) do { _Pragma("unroll") for (int n = 0; n < 2; ++n) _Pragma("unroll") for (int k = 0; k < 2; ++k) dst[n][k] = *(const PG8_LAS bf16x8*)(lds + PG8_SB(b, h) + boff + n * 2048 + k * 1024); } while (0)
#define PG8_MMA(ai, bj, At, Bt) do { __builtin_amdgcn_s_setprio(1); _Pragma("unroll") for (int m = 0; m < 4; ++m) _Pragma("unroll") for (int n = 0; n < 2; ++n) _Pragma("unroll") for (int k = 0; k < 2; ++k) \
        acc[ai][bj][m][n] = __builtin_amdgcn_mfma_f32_16x16x32_bf16(Bt[n][k], At[m][k], acc[ai][bj][m][n], 0, 0, 0); \
        if (GEMM_XMFMA) { bf16x8 z_ = {0, 0, 0, 0, 0, 0, 0, 0}; asm volatile("" : "+v"(z_)); _Pragma("unroll") for (int m = 0; m < 4; ++m) _Pragma("unroll") for (int n = 0; n < 2; ++n) acc[ai][bj][m][n] = __builtin_amdgcn_mfma_f32_16x16x32_bf16(z_, At[m][0], acc[ai][bj][m][n], 0, 0, 0); } \
        __builtin_amdgcn_s_setprio(0); } while (0)
#define PG8_WAIT_V(n) asm volatile("s_waitcnt vmcnt(" #n ")" ::: "memory")
#define PG8_WAIT_L(n) asm volatile("s_waitcnt lgkmcnt(" #n ")" ::: "memory")
#define PG8_BAR __builtin_amdgcn_s_barrier()
#define PG8_SCHED __builtin_amdgcn_sched_barrier(0)
    Unit cur, nxt; int ui = 0; float epre[8];
    if (!S.next(0, cur)) return;
    f32x4 acc[2][2][4][2];
#pragma unroll
    for (int a = 0; a < 2; ++a)
#pragma unroll
        for (int b = 0; b < 2; ++b)
#pragma unroll
            for (int m = 0; m < 4; ++m)
#pragma unroll
                for (int n = 0; n < 2; ++n) acc[a][b][m][n] = (f32x4){0.f, 0.f, 0.f, 0.f};
    bf16x8 At[4][2], B0[2][2], B1[2][2];
    const char* cA = (const char*)g.A + (size_t)cur.pm * tstep; const char* cB = (const char*)g.Bt + (size_t)cur.pn * tstep;
    S.a_ready(cur);
    E.prefetch(cur, wr, fr, epre);
    if constexpr (SP2) {
        PG8_STAGE(PG8_SB(0, 0), cB, voffB); PG8_STAGE(PG8_SB(0, 1), cB + hstep, voffB); PG8_STAGE(PG8_SA(0, 0), cA, voffA); PG8_STAGE(PG8_SA(0, 1), cA + hstep, voffA);
        if (wr == 1) PG8_BAR;
        PG8_WAIT_V(2); PG8_BAR;
        PG8_STAGE(PG8_SB(1, 0), cB + kstep, voffB); PG8_STAGE(PG8_SA(1, 0), cA + kstep, voffA); PG8_STAGE(PG8_SB(1, 1), cB + hstep + kstep, voffB);
        PG8_WAIT_V(6); PG8_BAR;
    } else {
        PG8_STAGE(PG8_SB(0, 0), cB, voffB); PG8_STAGE(PG8_SA(0, 0), cA, voffA); PG8_STAGE(PG8_SB(0, 1), cB + hstep, voffB); PG8_STAGE(PG8_SA(0, 1), cA + hstep, voffA);
        if (wr == 1) PG8_BAR;
        PG8_WAIT_V(4); PG8_BAR;
        PG8_STAGE(PG8_SB(1, 0), cB + kstep, voffB); PG8_STAGE(PG8_SA(1, 0), cA + kstep, voffA); PG8_STAGE(PG8_SB(1, 1), cB + hstep + kstep, voffB);
        PG8_WAIT_V(6); PG8_BAR;
    }
    for (;;) {
        const bool has_next = S.next(ui + 1, nxt);
        const char* nA = has_next ? (const char*)g.A + (size_t)nxt.pm * tstep : cA; const char* nB = has_next ? (const char*)g.Bt + (size_t)nxt.pn * tstep : cB;
        for (int t = 0; t < nt; t += 2) {
            const bool last = (t == nt - 2);
            const char* a1 = cA + (size_t)(t + 1) * kstep;
            const char* a2 = last ? nA : cA + (size_t)(t + 2) * kstep; const char* b2 = last ? nB : cB + (size_t)(t + 2) * kstep;
            const char* a3 = a2 + kstep; const char* b3 = b2 + kstep;
            if (last && has_next) S.a_ready(nxt);
            if constexpr (SP2) {
            PG8_LDB(B0, 0, 0); PG8_LDB(B1, 0, 1); PG8_SCHED; PG8_LDA(At, 0, 0); PG8_STAGE(PG8_SA(1, 1), a1 + hstep, voffA);
            PG8_WAIT_V(8); PG8_WAIT_L(0); PG8_BAR; PG8_MMA(0, 0, At, B0); PG8_MMA(0, 1, At, B1); PG8_BAR; PG8_SCHED;
            if constexpr (DMA_IN_MMA) {
            PG8_LDA(At, 0, 1);
            PG8_WAIT_V(2); PG8_WAIT_L(0); PG8_BAR; PG8_STAGE(PG8_SB(0, 0), b2, voffB); PG8_SCHED; PG8_MMA(1, 0, At, B0); PG8_SCHED; PG8_STAGE(PG8_SB(0, 1), b2 + hstep, voffB); PG8_SCHED; PG8_MMA(1, 1, At, B1); PG8_SCHED; PG8_STAGE(PG8_SA(0, 0), a2, voffA); PG8_BAR; PG8_SCHED;
            } else {
            PG8_LDA(At, 0, 1); PG8_STAGE(PG8_SB(0, 0), b2, voffB); PG8_STAGE(PG8_SB(0, 1), b2 + hstep, voffB); PG8_STAGE(PG8_SA(0, 0), a2, voffA);
            PG8_WAIT_V(8); PG8_WAIT_L(0); PG8_BAR; PG8_MMA(1, 0, At, B0); PG8_MMA(1, 1, At, B1); PG8_BAR; PG8_SCHED;
            }
            PG8_LDB(B0, 1, 0); PG8_LDB(B1, 1, 1); PG8_SCHED; PG8_LDA(At, 1, 0); PG8_STAGE(PG8_SA(0, 1), a2 + hstep, voffA);
            PG8_WAIT_V(8); PG8_WAIT_L(0); PG8_BAR; PG8_MMA(0, 0, At, B0); PG8_MMA(0, 1, At, B1); PG8_BAR; PG8_SCHED;
            if constexpr (DMA_IN_MMA) {
            PG8_LDA(At, 1, 1);
            PG8_WAIT_V(2); PG8_WAIT_L(0); PG8_BAR; PG8_STAGE(PG8_SB(1, 0), b3, voffB); PG8_SCHED; PG8_MMA(1, 0, At, B0); PG8_SCHED; PG8_STAGE(PG8_SB(1, 1), b3 + hstep, voffB); PG8_SCHED; PG8_MMA(1, 1, At, B1); PG8_SCHED; PG8_STAGE(PG8_SA(1, 0), a3, voffA); PG8_BAR; PG8_SCHED;
            } else {
            PG8_LDA(At, 1, 1); PG8_STAGE(PG8_SB(1, 0), b3, voffB); PG8_STAGE(PG8_SB(1, 1), b3 + hstep, voffB); PG8_STAGE(PG8_SA(1, 0), a3, voffA);
            PG8_WAIT_V(8); PG8_WAIT_L(0); PG8_BAR; PG8_MMA(1, 0, At, B0); PG8_MMA(1, 1, At, B1); PG8_BAR; PG8_SCHED;
            }
            } else {
            PG8_LDB(B0, 0, 0); PG8_SCHED; PG8_LDA(At, 0, 0); PG8_STAGE(PG8_SA(1, 1), a1 + hstep, voffA);
            PG8_WAIT_L(8); PG8_BAR; PG8_WAIT_L(0); PG8_MMA(0, 0, At, B0); PG8_BAR; PG8_SCHED;
            PG8_LDB(B1, 0, 1); PG8_STAGE(PG8_SB(0, 0), b2, voffB);
            PG8_BAR; PG8_WAIT_L(0); PG8_MMA(0, 1, At, B1); PG8_BAR;
            PG8_LDA(At, 0, 1); PG8_STAGE(PG8_SA(0, 0), a2, voffA);
            PG8_BAR; PG8_WAIT_L(0); PG8_MMA(1, 0, At, B0); PG8_BAR; PG8_SCHED;
            PG8_STAGE(PG8_SB(0, 1), b2 + hstep, voffB);
            PG8_WAIT_V(6); PG8_BAR; PG8_MMA(1, 1, At, B1); PG8_BAR;
            PG8_LDB(B0, 1, 0); PG8_SCHED; PG8_LDA(At, 1, 0); PG8_STAGE(PG8_SA(0, 1), a2 + hstep, voffA);
            PG8_WAIT_L(8); PG8_BAR; PG8_WAIT_L(0); PG8_MMA(0, 0, At, B0); PG8_BAR; PG8_SCHED;
            PG8_LDB(B1, 1, 1); PG8_STAGE(PG8_SB(1, 0), b3, voffB);
            PG8_BAR; PG8_WAIT_L(0); PG8_MMA(0, 1, At, B1); PG8_BAR;
            PG8_LDA(At, 1, 1); PG8_STAGE(PG8_SA(1, 0), a3, voffA);
            PG8_BAR; PG8_WAIT_L(0); PG8_MMA(1, 0, At, B0); PG8_BAR; PG8_SCHED;
            PG8_STAGE(PG8_SB(1, 1), b3 + hstep, voffB);
            PG8_WAIT_V(6); PG8_BAR; PG8_MMA(1, 1, At, B1); PG8_BAR;
            }
        }
        if constexpr (ALIGN_EPI) { if (wr == 0) PG8_BAR; }
        if constexpr (!Epi::AFTER_DRAIN) { E(acc, cur, wr, wc, fr, fq, epre); S.done(cur); }
        if (!has_next) break;
#pragma unroll
        for (int a = 0; a < 2; ++a)
#pragma unroll
            for (int b = 0; b < 2; ++b)
#pragma unroll
                for (int m = 0; m < 4; ++m)
#pragma unroll
                    for (int n = 0; n < 2; ++n) acc[a][b][m][n] = (f32x4){0.f, 0.f, 0.f, 0.f};
        cur = nxt; cA = nA; cB = nB; ++ui;
        E.prefetch(cur, wr, fr, epre);
        if constexpr (ALIGN_EPI) { if (wr == 1) PG8_BAR; }
    }
    PG8_WAIT_V(0);
    if constexpr (!ALIGN_EPI) { if (wr == 0) PG8_BAR; }
    PG8_BAR;
    if constexpr (Epi::AFTER_DRAIN) { E.fused(acc, cur, wr, wc, fr, fq, lds, wid, lane); S.done(cur); }
#undef PG8_SA
#undef PG8_SB
#undef PG8_STAGE
#undef PG8_LDA
#undef PG8_LDB
#undef PG8_MMA
#undef PG8_WAIT_V
#undef PG8_WAIT_L
#undef PG8_BAR
#undef PG8_SCHED
}
}
namespace att {
#ifndef ATT_XMFMA
#define ATT_XMFMA 0
#endif
#ifndef ATT_STAGGER
#define ATT_STAGGER 0
#endif
#ifndef SB_RING
#define SB_RING 1
#endif
#ifndef ATT_XBAR
#define ATT_XBAR 0
#endif
#define ALAS __attribute__((address_space(3)))
typedef short bf16x8 __attribute__((ext_vector_type(8)));
typedef short s16x4 __attribute__((ext_vector_type(4)));
typedef float f32x16 __attribute__((ext_vector_type(16)));
typedef float f32x4 __attribute__((ext_vector_type(4)));
typedef unsigned u32x4 __attribute__((ext_vector_type(4)));
typedef unsigned short bf16_t;
constexpr int NW = 8, QBLK = 32, KVBLK = 64, QB = NW * QBLK;
constexpr int SHM_V = KVBLK * 128 * 2, SHM_K = KVBLK * 128 * 2;
constexpr int OFF_V = 0, OFF_K = 2 * SHM_V, OFF_WS = OFF_K + 2 * SHM_K, OFF_CUM = OFF_WS + NW * 64 * 4, OFF_MISC = OFF_CUM + 2048 * 4, ATT_LDS_BYTES = OFF_MISC + 256;
constexpr float LOG2E = 1.4426950408889634f;
#define KSWZ(row, colB) ((row) * 256 + ((colB) ^ (((row) & 7) << 4)))
#define SBAR() __builtin_amdgcn_sched_barrier(0)
__device__ __forceinline__ int v_st(int k, int c) { const int kk = (k & ~0xC) | ((k & 4) << 1) | ((k & 8) >> 1); return ((kk >> 3) * 4 + (c >> 5)) * 512 + ((kk & 7) * 32 + (c & 31)) * 2; }
__device__ __forceinline__ int v_rd_base(int lane) { return ((lane & 3) << 3) | (((lane >> 2) & 3) << 6) | (((lane >> 4) & 1) << 5) | (((lane >> 5) & 1) << 8); }
constexpr int v_rd_off(int d0, int ks, int half) { return d0 * 512 + ks * 4096 + half * 2048; }
__device__ __forceinline__ int crow(int r, int hi) { return (r & 3) + 8 * (r >> 2) + 4 * hi; }
__device__ __forceinline__ unsigned cvtpk(float lo, float hi) { unsigned r; asm volatile("v_cvt_pk_bf16_f32 %0, %1, %2" : "=v"(r) : "v"(lo), "v"(hi)); return r; }
__device__ __forceinline__ void mask_tile(f32x16& p0, f32x16& p1, int dq) {
    const float NEG = -__builtin_inff();
#pragma unroll
    for (int r = 0; r < 16; ++r) { const int c = (r & 3) + 8 * (r >> 2);
        if (dq - c < 0) p0[r] = NEG;
        if (dq - c - 32 < 0) p1[r] = NEG; }
}
__device__ __forceinline__ void pack_p(const f32x16& p0, const f32x16& p1, bf16x8& pa0, bf16x8& pa1, bf16x8& pa2, bf16x8& pa3) {
#define PK4(P, B_, OUT) do { unsigned a0 = cvtpk(P[B_+0], P[B_+1]), a1 = cvtpk(P[B_+2], P[B_+3]); unsigned b0 = cvtpk(P[B_+4], P[B_+5]), b1 = cvtpk(P[B_+6], P[B_+7]); \
        auto r0 = __builtin_amdgcn_permlane32_swap(a0, b0, false, false); auto r1 = __builtin_amdgcn_permlane32_swap(a1, b1, false, false); \
        u32x4 w = {r0[0], r1[0], r0[1], r1[1]}; OUT = __builtin_bit_cast(bf16x8, w); } while (0)
    PK4(p0, 0, pa0); PK4(p0, 8, pa1); PK4(p1, 0, pa2); PK4(p1, 8, pa3);
#undef PK4
}
template <int KB, int ND>
__device__ __forceinline__ void qkt(f32x16& p0, f32x16& p1, const ALAS char* K_lds, int r32, int hi, const bf16x8* qr, int koff) {
    p0 = f32x16{}; p1 = f32x16{};
    const ALAS char* kb[4];
#pragma unroll
    for (int dd = 0; dd < 4; ++dd) kb[dd] = K_lds + KB * SHM_K + KSWZ(r32, (dd * 16 + hi * 8) * 2) + koff;
#pragma unroll
    for (int d0 = 0; d0 < ND; ++d0) { const ALAS char* a = kb[d0 & 3] + (d0 >> 2) * 128;
        const bf16x8 b0 = *(const ALAS bf16x8*)(a);
        const bf16x8 b1 = *(const ALAS bf16x8*)(a + 32 * 256);
        p0 = __builtin_amdgcn_mfma_f32_32x32x16_bf16(b0, qr[d0], p0, 0, 0, 0);
        p1 = __builtin_amdgcn_mfma_f32_32x32x16_bf16(b1, qr[d0], p1, 0, 0, 0);
        if (ATT_XMFMA && d0 < 4) { bf16x8 z = {0, 0, 0, 0, 0, 0, 0, 0}; asm volatile("" : "+v"(z));
            p0 = __builtin_amdgcn_mfma_f32_32x32x16_bf16(b0, z, p0, 0, 0, 0); p1 = __builtin_amdgcn_mfma_f32_32x32x16_bf16(b1, z, p1, 0, 0, 0); } }
}
template <int VB>
__device__ __forceinline__ void pv_tile(f32x16* o, int vb0, bf16x8 pa0, bf16x8 pa1, bf16x8 pa2, bf16x8 pa3) {
#define TRRD(dst, off) asm volatile("ds_read_b64_tr_b16 %0, %1 offset:%2" : "=&v"(dst) : "v"(vb0), "i"(off) : "memory")
#define PV_D0(d0) do { s16x4 l0, l1, l2, l3, h0, h1, h2, h3; constexpr int b_ = VB * SHM_V + v_rd_off(d0, 0, 0); \
        TRRD(l0, b_); TRRD(h0, b_ + 2048); TRRD(l1, b_ + 4096); TRRD(h1, b_ + 6144); TRRD(l2, b_ + 8192); TRRD(h2, b_ + 10240); TRRD(l3, b_ + 12288); TRRD(h3, b_ + 14336); \
        asm volatile("s_waitcnt lgkmcnt(0)" ::: "memory"); SBAR(); \
        o[d0] = __builtin_amdgcn_mfma_f32_32x32x16_bf16(pa0, (bf16x8){l0[0], l0[1], l0[2], l0[3], h0[0], h0[1], h0[2], h0[3]}, o[d0], 0, 0, 0); \
        o[d0] = __builtin_amdgcn_mfma_f32_32x32x16_bf16(pa1, (bf16x8){l1[0], l1[1], l1[2], l1[3], h1[0], h1[1], h1[2], h1[3]}, o[d0], 0, 0, 0); \
        o[d0] = __builtin_amdgcn_mfma_f32_32x32x16_bf16(pa2, (bf16x8){l2[0], l2[1], l2[2], l2[3], h2[0], h2[1], h2[2], h2[3]}, o[d0], 0, 0, 0); \
        o[d0] = __builtin_amdgcn_mfma_f32_32x32x16_bf16(pa3, (bf16x8){l3[0], l3[1], l3[2], l3[3], h3[0], h3[1], h3[2], h3[3]}, o[d0], 0, 0, 0); } while (0)
    PV_D0(0); PV_D0(1); PV_D0(2); PV_D0(3);
#undef PV_D0
#undef TRRD
}
__device__ __forceinline__ float swap_max(float v) { auto rr = __builtin_amdgcn_permlane32_swap(__float_as_uint(v), __float_as_uint(v), false, false); return fmaxf(__uint_as_float(rr[0]), __uint_as_float(rr[1])); }
__device__ __forceinline__ float swap_sum(float v) { auto rr = __builtin_amdgcn_permlane32_swap(__float_as_uint(v), __float_as_uint(v), false, false); return __uint_as_float(rr[0]) + __uint_as_float(rr[1]); }

__device__ __forceinline__ void store_o(const f32x16* o, const float* rli, bf16_t* Ow, int op, ALAS char* lds, int wid, int lane, int r32, int hi) {
    __syncthreads();
    ALAS char* stg = lds + wid * 8192;
#pragma unroll
    for (int r = 0; r < 16; ++r) { const int orow = crow(r, hi);
#pragma unroll
        for (int d0 = 0; d0 < 4; ++d0) { const float v = o[d0][r] * rli[r]; const float vn = __builtin_bit_cast(float, __builtin_amdgcn_update_dpp(0, __builtin_bit_cast(int, v), 0xB1, 0xF, 0xF, true));
            if ((r32 & 1) == 0) *(ALAS unsigned*)(stg + orow * 256 + (d0 * 32 + r32) * 2) = cvtpk(v, vn); } }
    asm volatile("s_waitcnt lgkmcnt(0)" ::: "memory");
#pragma unroll
    for (int i = 0; i < 8; ++i) { const int row = i * 4 + (lane >> 4), ch = lane & 15; const u32x4 v = *(const ALAS u32x4*)(stg + row * 256 + ch * 16); *(u32x4*)(Ow + (size_t)row * op + ch * 8) = v; }
    __syncthreads();
}
template <int MODE>
__device__ __forceinline__ void attn_unit(const bf16_t* Q, int qp, const bf16_t* K, const bf16_t* V, int kvp, bf16_t* O, int op, int pos0, int NT, int koff, const float* logf, ALAS char* lds) {
    constexpr int ND = (MODE == 0) ? 4 : 8;
    constexpr bool CAUSAL = (MODE != 3), SB = (MODE == 1);
    constexpr float SCALE = (MODE == 0) ? 0.125f : 0.08838834764831845f;
    constexpr float C2 = SCALE * LOG2E;
    constexpr float THR2 = 8.f * LOG2E;
    int tid_ = threadIdx.x; asm volatile("" : "+v"(tid_));
    const int tid = tid_, wid = __builtin_amdgcn_readfirstlane(tid >> 6), lane = tid & 63, r32 = lane & 31, hi = lane >> 5;
    const ALAS char* V_lds = lds + OFF_V; const ALAS char* K_lds = lds + OFF_K;
    ALAS float* wsf = (ALAS float*)(lds + OFF_WS) + wid * 64; ALAS float* li_l = wsf; ALAS float* al_l = wsf + 32;
    ALAS float* cum2 = (ALAS float*)(lds + OFF_CUM);
    const int sr = tid >> 4, sc = (tid & 15) * 8, vst0 = v_st(sr, sc), vst1 = v_st(32 + sr, sc), kws = KSWZ(sr, sc * 2);
    const int vb0 = (int)(uintptr_t)(V_lds) + v_rd_base(lane);
    if constexpr (MODE == 2) {
        const f32x4 v = *(const f32x4*)(logf + 4 * tid);
        const float a0 = v[0], a1 = a0 + v[1], a2 = a1 + v[2], a3 = a2 + v[3];
        float s = a3;
#pragma unroll
        for (int off = 1; off < 64; off <<= 1) { const float t = __shfl_up(s, off); if (lane >= off) s += t; }
        ALAS float* wt = (ALAS float*)(lds + OFF_MISC) + 16;
        if (lane == 63) wt[wid] = s;
        __syncthreads();
        float base = 0.f, refs = 0.f;
#pragma unroll
        for (int w = 0; w < NW; ++w) { const float t = wt[w]; if (w < wid) base += t; if (w <= (pos0 >> 8)) refs += t; }
        const float ex = s - a3 + base - refs;
        f32x4 c; c[0] = (ex + a0) * LOG2E; c[1] = (ex + a1) * LOG2E; c[2] = (ex + a2) * LOG2E; c[3] = (ex + a3) * LOG2E;
        *(ALAS f32x4*)(cum2 + 4 * tid) = c;
        __syncthreads();
    }
    bf16x8 qr[ND];
#pragma unroll
    for (int d0 = 0; d0 < ND; ++d0) qr[d0] = *(const bf16x8*)(Q + (size_t)(wid * QBLK + r32) * qp + d0 * 16 + hi * 8);
    const int qlo = pos0 + wid * QBLK;
    const int qm = pos0 + wid * QBLK + r32 - 4 * hi - (SB ? 1 : 0);
    float m_reg = -1e30f, l_reg = 0.f, carry = 0.f; f32x16 o[4] = {};
    bf16x8 st_k0, st_k1, st_v0, st_v1;
#define TILE_OF(it) (SB ? (NT - 1 - (it)) : (it))
#define GROW(p, k0, rr) ((p) + (size_t)((k0) + (rr)) * kvp + sc)
#define SLOAD(k0) do { st_v0 = *(const bf16x8*)GROW(V, k0, sr); st_v1 = *(const bf16x8*)GROW(V, k0, 32 + sr); st_k0 = *(const bf16x8*)GROW(K, k0, sr); st_k1 = *(const bf16x8*)GROW(K, k0, 32 + sr); } while (0)
#define SWRITE(bf) do { *(ALAS bf16x8*)(lds + OFF_K + (bf) * SHM_K + kws) = st_k0; *(ALAS bf16x8*)(lds + OFF_K + (bf) * SHM_K + kws + 32 * 256) = st_k1; \
                        *(ALAS bf16x8*)(lds + OFF_V + (bf) * SHM_V + vst0) = st_v0; *(ALAS bf16x8*)(lds + OFF_V + (bf) * SHM_V + vst1) = st_v1; } while (0)
    SLOAD(TILE_OF(0) * KVBLK); SWRITE(0);
    __syncthreads();
    f32x16 p0, p1; bf16x8 pa0, pa1, pa2, pa3; bool wdone = false, stop = false;
    ALAS unsigned* dflag = (ALAS unsigned*)(lds + OFF_MISC + 128);
#define STEP(it, BUF) do { \
        const int kb_ = TILE_OF(it) * KVBLK; \
        if ((it) + 1 < NT) SLOAD(TILE_OF((it) + 1) * KVBLK); \
          \
        const bool act_ = SB ? (kb_ < qlo + QBLK - 1 && !wdone) : (CAUSAL ? (kb_ <= qlo + QBLK - 1) : true); \
        if (act_) { \
        SBAR(); qkt<BUF, ND>(p0, p1, K_lds, r32, hi, qr, koff); SBAR(); \
        if constexpr (SB) { \
            _Pragma("unroll") for (int r = 0; r < 16; ++r) { p0[r] *= C2; p1[r] *= C2; } \
            if (kb_ + KVBLK - 1 > qlo - 1) mask_tile(p0, p1, qm - kb_); \
            float G0[4], G1[4]; \
            _Pragma("unroll") for (int g = 0; g < 4; ++g) { float s0 = 0.f, s1 = 0.f; \
                _Pragma("unroll") for (int k = 3; k >= 0; --k) { const int r = 4 * g + k; \
                    { const float z = p0[r]; const float sp = fmaxf(z, 0.f) + __builtin_amdgcn_logf(1.0f + __builtin_amdgcn_exp2f(-fabsf(z))); p0[r] = (z - sp) + s0; s0 -= sp; } \
                    { const float z = p1[r]; const float sp = fmaxf(z, 0.f) + __builtin_amdgcn_logf(1.0f + __builtin_amdgcn_exp2f(-fabsf(z))); p1[r] = (z - sp) + s1; s1 -= sp; } } \
                G0[g] = s0; G1[g] = s1; } \
            float run = carry; float offv[8]; \
            _Pragma("unroll") for (int b = 7; b >= 0; --b) { const float gsum = (b >= 4) ? G1[b - 4] : G0[b]; \
                auto rr = __builtin_amdgcn_permlane32_swap(__float_as_uint(gsum), __float_as_uint(gsum), false, false); \
                const float glo = __uint_as_float(rr[0]), ghi = __uint_as_float(rr[1]); \
                offv[b] = run + (hi == 0 ? ghi : 0.f); run += glo + ghi; } \
            carry = run; wdone = __all(carry < -152.0f);     \
            _Pragma("unroll") for (int r = 0; r < 16; ++r) { p0[r] = __builtin_amdgcn_exp2f(p0[r] + offv[r >> 2]); p1[r] = __builtin_amdgcn_exp2f(p1[r] + offv[4 + (r >> 2)]); } \
        } else { \
            if constexpr (MODE == 2) { \
                _Pragma("unroll") for (int g = 0; g < 4; ++g) { const f32x4 c0 = *(const ALAS f32x4*)(cum2 + kb_ + 8 * g + 4 * hi); const f32x4 c1 = *(const ALAS f32x4*)(cum2 + kb_ + 32 + 8 * g + 4 * hi); \
                    _Pragma("unroll") for (int k = 0; k < 4; ++k) { p0[4 * g + k] = fmaf(p0[4 * g + k], C2, -c0[k]); p1[4 * g + k] = fmaf(p1[4 * g + k], C2, -c1[k]); } } \
            } else { _Pragma("unroll") for (int r = 0; r < 16; ++r) { p0[r] *= C2; p1[r] *= C2; } } \
            if constexpr (CAUSAL) { if (kb_ + KVBLK - 1 > qlo) mask_tile(p0, p1, qm - kb_); } \
            float pmax = p0[0]; \
            _Pragma("unroll") for (int r = 1; r < 16; ++r) pmax = fmaxf(pmax, p0[r]); \
            _Pragma("unroll") for (int r = 0; r < 16; ++r) pmax = fmaxf(pmax, p1[r]); \
            pmax = swap_max(pmax); \
            float mn, alpha; \
            if (__all(pmax - m_reg <= THR2)) { mn = m_reg; alpha = 1.f; } \
            else { mn = fmaxf(m_reg, pmax); alpha = __builtin_amdgcn_exp2f(m_reg - mn); m_reg = mn; } \
            float ps = 0.f; \
            _Pragma("unroll") for (int r = 0; r < 16; ++r) { p0[r] = __builtin_amdgcn_exp2f(p0[r] - mn); p1[r] = __builtin_amdgcn_exp2f(p1[r] - mn); ps += p0[r] + p1[r]; } \
            ps = swap_sum(ps); l_reg = l_reg * alpha + ps; \
            if (__any(alpha < 1.f)) { if (hi == 0) al_l[r32] = alpha; asm volatile("s_waitcnt lgkmcnt(0)" ::: "memory"); \
                _Pragma("unroll") for (int d_ = 0; d_ < 4; ++d_) _Pragma("unroll") for (int r = 0; r < 16; ++r) o[d_][r] *= al_l[crow(r, hi)]; } \
        } \
        pack_p(p0, p1, pa0, pa1, pa2, pa3); SBAR(); \
        pv_tile<BUF>(o, vb0, pa0, pa1, pa2, pa3); SBAR(); \
        } \
        if ((it) + 1 < NT) SWRITE((BUF) ^ 1); \
        if constexpr (SB) { if (lane == 0) dflag[(BUF) * 8 + wid] = wdone ? 1u : 0u; } \
        __syncthreads(); \
        if constexpr (SB) { const u32x4 f0 = *(const ALAS u32x4*)(dflag + (BUF) * 8), f1 = *(const ALAS u32x4*)(dflag + (BUF) * 8 + 4); \
            stop = ((f0[0] & f0[1] & f0[2] & f0[3] & f1[0] & f1[1] & f1[2] & f1[3]) != 0u); } \
        } while (0)
    for (int it = 0; it < NT; it += 2) { STEP(it, 0); if (stop) break; STEP(it + 1, 1); if (stop) break; }
#undef STEP
#undef SWRITE
#undef SLOAD
#undef GROW
#undef TILE_OF
    float rli[16];
    if constexpr (SB) {
#pragma unroll
        for (int r = 0; r < 16; ++r) rli[r] = 1.f;
    } else {
        if (hi == 0) li_l[r32] = l_reg; asm volatile("s_waitcnt lgkmcnt(0)" ::: "memory");
#pragma unroll
        for (int r = 0; r < 16; ++r) rli[r] = __builtin_amdgcn_rcpf(li_l[crow(r, hi)]);
    }
    store_o(o, rli, O + (size_t)(wid * QBLK) * op, op, lds, wid, lane, r32, hi);
}

__device__ __forceinline__ void attn_unit_sb4(const bf16_t* Q, int qp, const bf16_t* K, const bf16_t* V, int kvp, bf16_t* O, int op, int pos0, int NT, ALAS char* lds) {
    constexpr int ND = 8; constexpr float C2 = 0.08838834764831845f * LOG2E;
    constexpr int R_V = 0, R_K = 4 * SHM_V;
    int tid_ = threadIdx.x; asm volatile("" : "+v"(tid_));
    const int tid = tid_, wid = __builtin_amdgcn_readfirstlane(tid >> 6), lane = tid & 63, r32 = lane & 31, hi = lane >> 5;
    const int sr = tid >> 4, sc = (tid & 15) * 8, vst0 = v_st(sr, sc), vst1 = v_st(32 + sr, sc), kws = KSWZ(sr, sc * 2);
    const int vbase = (int)(uintptr_t)(lds + R_V) + v_rd_base(lane);
    bf16x8 qr[ND];
#pragma unroll
    for (int d0 = 0; d0 < ND; ++d0) qr[d0] = *(const bf16x8*)(Q + (size_t)(wid * QBLK + r32) * qp + d0 * 16 + hi * 8);
    const int qlo = pos0 + wid * QBLK;
    const int qm = pos0 + wid * QBLK + r32 - 4 * hi - 1;
    const int bw = wid >> 1;
    float carry = 1.f; f32x16 o[4] = {};
#define GROW(p, kk, rr) ((p) + (size_t)((kk) + (rr)) * kvp + sc)
#define SLOADX(S, kk) do { S##v0 = *(const bf16x8*)GROW(V, kk, sr); S##v1 = *(const bf16x8*)GROW(V, kk, 32 + sr); S##k0 = *(const bf16x8*)GROW(K, kk, sr); S##k1 = *(const bf16x8*)GROW(K, kk, 32 + sr); } while (0)
#define SWRITEX(S, slot) do { *(ALAS bf16x8*)(lds + R_K + (slot) * SHM_K + kws) = S##k0; *(ALAS bf16x8*)(lds + R_K + (slot) * SHM_K + kws + 32 * 256) = S##k1; \
                              *(ALAS bf16x8*)(lds + R_V + (slot) * SHM_V + vst0) = S##v0; *(ALAS bf16x8*)(lds + R_V + (slot) * SHM_V + vst1) = S##v1; } while (0)
    { bf16x8 a_k0, a_k1, a_v0, a_v1, b_k0, b_k1, b_v0, b_v1, c_k0, c_k1, c_v0, c_v1, d_k0, d_k1, d_v0, d_v1;
      SLOADX(a_, (NT - 4) * KVBLK); SLOADX(b_, (NT - 3) * KVBLK); SLOADX(c_, (NT - 2) * KVBLK); SLOADX(d_, (NT - 1) * KVBLK);
      SWRITEX(a_, 0); SWRITEX(b_, 1); SWRITEX(c_, 2); SWRITEX(d_, 3); }
    __syncthreads();
    bf16x8 s_k0, s_k1, s_v0, s_v1;
    f32x16 p0, p1; bf16x8 pa0, pa1, pa2, pa3; bool wdone = false;
    ALAS unsigned* dflag = (ALAS unsigned*)(lds + 131072 + 4096);
    for (int s = 0; s < NT; ++s) {
        const int tl = NT - 5 - s;
        if (tl >= 0) SLOADX(s_, tl * KVBLK);
        const int t = NT - 4 + bw - s;
        if (t >= 0 && !wdone) { const int kb_ = t * KVBLK, slot = t & 3;
            SBAR(); qkt<0, ND>(p0, p1, lds + R_K + slot * SHM_K, r32, hi, qr, 0); SBAR();
#pragma unroll
            for (int r = 0; r < 16; ++r) { p0[r] *= C2; p1[r] *= C2; }
            if (kb_ + KVBLK - 1 > qlo - 1) mask_tile(p0, p1, qm - kb_);
            float G0[4], G1[4];
#pragma unroll
            for (int g = 0; g < 4; ++g) { float s0 = 1.f, s1 = 1.f;
#pragma unroll
                for (int k = 3; k >= 0; --k) { const int r = 4 * g + k;
                    { const float z = p0[r]; const float e = __builtin_amdgcn_exp2f(-fabsf(z)); const float rc = __builtin_amdgcn_rcpf(1.0f + e); const float er = e * rc; const bool pos = z > 0.f;
                      p0[r] = (pos ? rc : er) * s0; s0 *= (pos ? er : rc); }
                    { const float z = p1[r]; const float e = __builtin_amdgcn_exp2f(-fabsf(z)); const float rc = __builtin_amdgcn_rcpf(1.0f + e); const float er = e * rc; const bool pos = z > 0.f;
                      p1[r] = (pos ? rc : er) * s1; s1 *= (pos ? er : rc); } }
                G0[g] = s0; G1[g] = s1; }
            float run = carry; float offv[8];
#pragma unroll
            for (int b = 7; b >= 0; --b) { const float gprod = (b >= 4) ? G1[b - 4] : G0[b];
                auto rr = __builtin_amdgcn_permlane32_swap(__float_as_uint(gprod), __float_as_uint(gprod), false, false);
                const float glo = __uint_as_float(rr[0]), ghi = __uint_as_float(rr[1]);
                offv[b] = (hi == 0) ? run * ghi : run; run *= glo * ghi; }
            carry = run; wdone = __all(carry == 0.0f);
#pragma unroll
            for (int r = 0; r < 16; ++r) { p0[r] *= offv[r >> 2]; p1[r] *= offv[4 + (r >> 2)]; }
            pack_p(p0, p1, pa0, pa1, pa2, pa3); SBAR();
            pv_tile<0>(o, vbase + slot * SHM_V, pa0, pa1, pa2, pa3); SBAR();
        }
        if (lane == 0) dflag[(s & 1) * 8 + wid] = (wdone || t <= 0) ? 1u : 0u;
        __syncthreads();
        const u32x4 f0 = *(const ALAS u32x4*)(dflag + (s & 1) * 8), f1 = *(const ALAS u32x4*)(dflag + (s & 1) * 8 + 4);
        if ((f0[0] & f0[1] & f0[2] & f0[3] & f1[0] & f1[1] & f1[2] & f1[3]) != 0u) break;
        if (tl >= 0) { SWRITEX(s_, tl & 3); __syncthreads(); }
    }
#undef SWRITEX
#undef SLOADX
#undef GROW
    float rli[16];
#pragma unroll
    for (int r = 0; r < 16; ++r) rli[r] = 1.f;
    store_o(o, rli, O + (size_t)(wid * QBLK) * op, op, lds, wid, lane, r32, hi);
}

template <int MODE>
__device__ __forceinline__ void partialSM(f32x16& p0, f32x16& p1, float& m_reg, float& alpha) {
    constexpr float SCALE = (MODE == 0) ? 0.125f : 0.08838834764831845f;
    constexpr float CS = (MODE == 2) ? 1.0f : SCALE * LOG2E, THR2 = 8.f * LOG2E;
    float pmax = p0[0];
#pragma unroll
    for (int r = 1; r < 16; ++r) pmax = fmaxf(pmax, p0[r]);
#pragma unroll
    for (int r = 0; r < 16; ++r) pmax = fmaxf(pmax, p1[r]);
    pmax = swap_max(pmax);
    float mn;
    if (__builtin_expect(__all((pmax - m_reg) * CS <= THR2), 1)) { mn = m_reg; alpha = 1.f; }
    else { mn = fmaxf(m_reg, pmax); alpha = __builtin_amdgcn_exp2f((m_reg - mn) * CS); m_reg = mn; }
    const float mnL = -mn * CS;
#pragma unroll
    for (int r = 0; r < 16; ++r) { p0[r] = fmaf(p0[r], CS, mnL); p1[r] = fmaf(p1[r], CS, mnL); }
#pragma unroll
    for (int r = 0; r < 16; ++r) p0[r] = __builtin_amdgcn_exp2f(p0[r]);
}
__device__ __forceinline__ void finishSM(f32x16& p0, f32x16& p1, float alpha, float& l_reg, bf16x8& pa0, bf16x8& pa1, bf16x8& pa2, bf16x8& pa3) {
#pragma unroll
    for (int r = 0; r < 16; ++r) p1[r] = __builtin_amdgcn_exp2f(p1[r]);
    float ps = 0.f;
#pragma unroll
    for (int r = 0; r < 16; ++r) ps += p0[r];
#pragma unroll
    for (int r = 0; r < 16; ++r) ps += p1[r];
    ps = swap_sum(ps);
    l_reg = l_reg * alpha + ps;
    pack_p(p0, p1, pa0, pa1, pa2, pa3);
}
template <int MODE, bool LEAD>
__device__ __forceinline__ void attn_unit_sm_(const bf16_t* Q, int qp, const bf16_t* K, const bf16_t* V, int kvp, bf16_t* O, int op, int pos0, int NT, int koff, const float* logf, ALAS char* lds) {
    static_assert(MODE == 0 || MODE == 2 || MODE == 3, "softmax modes");
    constexpr int ND = (MODE == 0) ? 4 : 8;
    constexpr bool CAUSAL = (MODE != 3);
    constexpr float C2 = 0.08838834764831845f * LOG2E;
    int tid_ = threadIdx.x; asm volatile("" : "+v"(tid_));
    const int tid = tid_, wid = __builtin_amdgcn_readfirstlane(tid >> 6), lane = tid & 63, r32 = lane & 31, hi = lane >> 5;
    const ALAS char* V_lds = lds + OFF_V; const ALAS char* K_lds = lds + OFF_K;
    ALAS float* wsf = (ALAS float*)(lds + OFF_WS) + wid * 64; ALAS float* li_l = wsf; ALAS float* al_l = wsf + 32;
    ALAS float* cum2 = (ALAS float*)(lds + OFF_CUM);
    const int sr = tid >> 4, sc = (tid & 15) * 8, vst0 = v_st(sr, sc), vst1 = v_st(32 + sr, sc), kws = KSWZ(sr, sc * 2);
    const int vb0 = (int)(uintptr_t)(V_lds) + v_rd_base(lane);
    if constexpr (MODE == 2) {
        const f32x4 v = *(const f32x4*)(logf + 4 * tid);
        const float a0 = v[0], a1 = a0 + v[1], a2 = a1 + v[2], a3 = a2 + v[3];
        float s = a3;
#pragma unroll
        for (int off = 1; off < 64; off <<= 1) { const float t = __shfl_up(s, off); if (lane >= off) s += t; }
        ALAS float* wt = (ALAS float*)(lds + OFF_MISC) + 16;
        if (lane == 63) wt[wid] = s;
        __syncthreads();
        float base = 0.f, refs = 0.f;
#pragma unroll
        for (int w = 0; w < NW; ++w) { const float t = wt[w]; if (w < wid) base += t; if (w <= (pos0 >> 8)) refs += t; }
        const float ex = s - a3 + base - refs;
        f32x4 c; c[0] = (ex + a0) * LOG2E; c[1] = (ex + a1) * LOG2E; c[2] = (ex + a2) * LOG2E; c[3] = (ex + a3) * LOG2E;
        *(ALAS f32x4*)(cum2 + 4 * tid) = c;
        __syncthreads();
    }
    bf16x8 qr[ND];
#pragma unroll
    for (int d0 = 0; d0 < ND; ++d0) qr[d0] = *(const bf16x8*)(Q + (size_t)(wid * QBLK + r32) * qp + d0 * 16 + hi * 8);
    const int qlo = pos0 + wid * QBLK, qm = qlo + r32 - 4 * hi;
    float m_reg = -1e30f, l_reg = 0.f; f32x16 o[4] = {};
    bf16x8 st_k0, st_k1, st_v0, st_v1;
#define GROW(p, k0, rr) ((p) + (size_t)((k0) + (rr)) * kvp + sc)
#define SLOAD(k0) do { st_v0 = *(const bf16x8*)GROW(V, k0, sr); st_v1 = *(const bf16x8*)GROW(V, k0, 32 + sr); st_k0 = *(const bf16x8*)GROW(K, k0, sr); st_k1 = *(const bf16x8*)GROW(K, k0, 32 + sr); } while (0)
#define SWRITE(bf) do { *(ALAS bf16x8*)(lds + OFF_K + (bf) * SHM_K + kws) = st_k0; *(ALAS bf16x8*)(lds + OFF_K + (bf) * SHM_K + kws + 32 * 256) = st_k1; \
                        *(ALAS bf16x8*)(lds + OFF_V + (bf) * SHM_V + vst0) = st_v0; *(ALAS bf16x8*)(lds + OFF_V + (bf) * SHM_V + vst1) = st_v1; } while (0)
#define RESC(a) do { if (__any((a) < 1.f)) { if (hi == 0) al_l[r32] = (a); asm volatile("s_waitcnt lgkmcnt(0)" ::: "memory"); \
        _Pragma("unroll") for (int d_ = 0; d_ < 4; ++d_) _Pragma("unroll") for (int r = 0; r < 16; ++r) o[d_][r] *= al_l[crow(r, hi)]; } } while (0)
#define PREP(P0_, P1_, t) do { const int kb_ = (t) * KVBLK; \
        if constexpr (MODE == 2) { \
            _Pragma("unroll") for (int g = 0; g < 4; ++g) { const f32x4 c0 = *(const ALAS f32x4*)(cum2 + kb_ + 8 * g + 4 * hi); const f32x4 c1 = *(const ALAS f32x4*)(cum2 + kb_ + 32 + 8 * g + 4 * hi); \
                _Pragma("unroll") for (int k = 0; k < 4; ++k) { P0_[4 * g + k] = fmaf(P0_[4 * g + k], C2, -c0[k]); P1_[4 * g + k] = fmaf(P1_[4 * g + k], C2, -c1[k]); } } } \
        if constexpr (CAUSAL) { if (kb_ + KVBLK - 1 > qlo) mask_tile(P0_, P1_, qm - kb_); } } while (0)
    f32x16 pA0, pA1, pB0, pB1; float alA, alB; bf16x8 pa0, pa1, pa2, pa3;
    SLOAD(0); SWRITE(0);
    __syncthreads();
    SLOAD(KVBLK);
    SBAR(); qkt<0, ND>(pA0, pA1, K_lds, r32, hi, qr, koff);
    PREP(pA0, pA1, 0); partialSM<MODE>(pA0, pA1, m_reg, alA);
    SWRITE(1);
    __syncthreads();
#define HALF_STEP(PX0, PX1, alX, PY0, PY1, alY, t, KB, VB, SBUF) do { \
        if ((t) + 1 < NT) { SLOAD(((t) + 1) * KVBLK); } \
          \
        if constexpr (LEAD) { \
            SBAR(); qkt<KB, ND>(PX0, PX1, K_lds, r32, hi, qr, koff); SBAR(); \
            finishSM(PY0, PY1, alY, l_reg, pa0, pa1, pa2, pa3); SBAR(); \
            pv_tile<VB>(o, vb0, pa0, pa1, pa2, pa3); SBAR(); \
            PREP(PX0, PX1, (t)); partialSM<MODE>(PX0, PX1, m_reg, alX); SBAR(); \
        } else { \
            SBAR(); finishSM(PY0, PY1, alY, l_reg, pa0, pa1, pa2, pa3); SBAR(); \
            qkt<KB, ND>(PX0, PX1, K_lds, r32, hi, qr, koff); SBAR(); \
            PREP(PX0, PX1, (t)); partialSM<MODE>(PX0, PX1, m_reg, alX); SBAR(); \
            pv_tile<VB>(o, vb0, pa0, pa1, pa2, pa3); SBAR(); \
        } \
        __syncthreads(); \
        if ((t) + 1 < NT) { SWRITE(SBUF); } \
        RESC(alX); __syncthreads(); if (ATT_XBAR) __syncthreads(); } while (0)
    for (int t = 1; t + 1 < NT; t += 2) {
        HALF_STEP(pB0, pB1, alB, pA0, pA1, alA, t, 1, 0, 0);
        HALF_STEP(pA0, pA1, alA, pB0, pB1, alB, t + 1, 0, 1, 1);
    }
    SBAR(); qkt<1, ND>(pB0, pB1, K_lds, r32, hi, qr, koff); SBAR();
    finishSM(pA0, pA1, alA, l_reg, pa0, pa1, pa2, pa3); SBAR();
    pv_tile<0>(o, vb0, pa0, pa1, pa2, pa3);
    PREP(pB0, pB1, NT - 1); partialSM<MODE>(pB0, pB1, m_reg, alB); RESC(alB);
    finishSM(pB0, pB1, alB, l_reg, pa0, pa1, pa2, pa3); SBAR();
    pv_tile<1>(o, vb0, pa0, pa1, pa2, pa3);
#undef HALF_STEP
#undef PREP
#undef RESC
#undef SWRITE
#undef SLOAD
#undef GROW
    if (hi == 0) li_l[r32] = l_reg; asm volatile("s_waitcnt lgkmcnt(0)" ::: "memory");
    float rli[16];
#pragma unroll
    for (int r = 0; r < 16; ++r) rli[r] = __builtin_amdgcn_rcpf(li_l[crow(r, hi)]);
    store_o(o, rli, O + (size_t)(wid * QBLK) * op, op, lds, wid, lane, r32, hi);
}
template <int MODE>
__device__ __forceinline__ void attn_unit_sm(const bf16_t* Q, int qp, const bf16_t* K, const bf16_t* V, int kvp, bf16_t* O, int op, int pos0, int NT, int koff, const float* logf, ALAS char* lds) {
    const int wid = __builtin_amdgcn_readfirstlane((int)threadIdx.x >> 6);
    if (!ATT_STAGGER || wid < 4) attn_unit_sm_<MODE, true>(Q, qp, K, V, kvp, O, op, pos0, NT, koff, logf, lds);
    else attn_unit_sm_<MODE, false>(Q, qp, K, V, kvp, O, op, pos0, NT, koff, logf, lds);
}
#undef SBAR
#undef KSWZ
}
#define GAS __attribute__((address_space(1)))
#define LAS __attribute__((address_space(3)))
typedef unsigned short bf16;
typedef unsigned v4u __attribute__((ext_vector_type(4)));
typedef float f32x4 __attribute__((ext_vector_type(4)));
typedef short bf16x8 __attribute__((ext_vector_type(8)));
typedef GAS unsigned gu32;
typedef GAS unsigned long long gu64;
#define RLX_AGENT __ATOMIC_RELAXED, __HIP_MEMORY_SCOPE_AGENT
#define LDS_WAIT() asm volatile("s_waitcnt lgkmcnt(0)" ::: "memory")
#define VM_WAIT() asm volatile("s_waitcnt vmcnt(0)" ::: "memory")
__device__ __forceinline__ unsigned long long rt() { return __builtin_amdgcn_s_memrealtime(); }
__device__ __forceinline__ unsigned f2bf(float f) { unsigned u = __builtin_bit_cast(unsigned, f); return (u + 0x7fffu + ((u >> 16) & 1u)) >> 16; }
__device__ __forceinline__ unsigned pk2(float lo, float hi) { return f2bf(lo) | (f2bf(hi) << 16); }

#define XB_TMO      128
#define XB_XCNT(j)  (256  + 64 * (j))
#define XB_XSUB(j)  (1280 + 64 * (j))
#define XB_XGEN(j)  (2304 + 64 * (j))
#define XB_TOP      3328
#define XB_TOPGEN   3392
#define XCD_BAR_WORDS 3456
#define XB_SPIN_CAP (1u << 18)

__device__ __forceinline__ unsigned xb_ld(unsigned* p)              { return __hip_atomic_load(p, __ATOMIC_RELAXED, __HIP_MEMORY_SCOPE_AGENT); }
__device__ __forceinline__ unsigned xb_add(unsigned* p, unsigned v) { return __hip_atomic_fetch_add(p, v, __ATOMIC_RELAXED, __HIP_MEMORY_SCOPE_AGENT); }
__device__ __forceinline__ unsigned xb_xcc_id() { return (unsigned)__builtin_amdgcn_s_getreg((3 << 11) | 20) & 0xFu; }
#define XB_SPIN(cond, bar) do { unsigned _sp = 0; while (cond) { __builtin_amdgcn_s_sleep(1); \
    if ((++_sp & 255u) == 0u) { if (xb_ld(&(bar)[XB_TMO])) break; if (_sp > XB_SPIN_CAP) { atomicAdd(&(bar)[XB_TMO], 1u); break; } } } } while (0)

#ifndef XB_SKIP_WB_ONE_XCC
#define XB_SKIP_WB_ONE_XCC 1
#endif
struct XcdBarrier {
    unsigned* bar; unsigned x;
    volatile LAS unsigned* st;
    unsigned npart;
};

__device__ __forceinline__ XcdBarrier xcd_barrier_post(unsigned* bar, volatile LAS unsigned* st, unsigned npart = 0u) {
    XcdBarrier b; b.bar = bar; b.x = xb_xcc_id(); b.st = st; b.npart = npart;
    if (threadIdx.x == 0) (void)xb_add(&bar[XB_XCNT(b.x)], 1u);
    return b;
}
__device__ __forceinline__ void xcd_barrier_complete(unsigned* bar, unsigned x, unsigned& nloc, unsigned& nx, unsigned npart) {
    const unsigned G = npart ? npart : gridDim.x * gridDim.y * gridDim.z;
    unsigned sum, cnt, mine, sp = 0u;
    for (;;) {
        sum = 0u; cnt = 0u; mine = 0u;
#pragma unroll
        for (unsigned j = 0; j < 16; ++j) { const unsigned c = xb_ld(&bar[XB_XCNT(j)]); sum += c; cnt += (c > 0u) ? 1u : 0u; mine = (j == x) ? c : mine; }
        if (sum == G) break;
        __builtin_amdgcn_s_sleep(1);
        if ((++sp & 255u) == 0u) { if (xb_ld(&bar[XB_TMO])) break; if (sp > XB_SPIN_CAP) { atomicAdd(&bar[XB_TMO], 1u); break; } }
    }
    nloc = mine > 0u ? mine : 1u; nx = cnt > 0u ? cnt : 1u;
}

__device__ __forceinline__ void xcd_barrier(const XcdBarrier& b) {
    asm volatile("s_waitcnt vmcnt(0)" ::: "memory");
    __syncthreads();
    if (threadIdx.x == 0) {
        unsigned* bar = b.bar;
        __builtin_amdgcn_s_waitcnt(0);
        unsigned nloc = b.st[0], nx = b.st[1];
        if (nloc == 0u) { xcd_barrier_complete(bar, b.x, nloc, nx, b.npart); b.st[0] = nloc; b.st[1] = nx; }
        const unsigned old = xb_add(&bar[XB_XSUB(b.x)], 1u);
        const unsigned gen = old / nloc;
        if (old + 1u == (gen + 1u) * nloc) {
            if (!XB_SKIP_WB_ONE_XCC || nx > 1u)
            __builtin_amdgcn_fence(__ATOMIC_RELEASE, "agent");
            asm volatile("s_waitcnt vmcnt(0)" ::: "memory");
            if (!XB_SKIP_WB_ONE_XCC || nx > 1u) {
            const unsigned og = xb_add(&bar[XB_TOP], 1u);
            const unsigned tg = og / nx;
            if (og + 1u == (tg + 1u) * nx) xb_add(&bar[XB_TOPGEN], 1u);
            else XB_SPIN(xb_ld(&bar[XB_TOPGEN]) == tg, bar);
            }
            __builtin_amdgcn_fence(__ATOMIC_ACQUIRE, "agent");
            xb_add(&bar[XB_XGEN(b.x)], 1u);
            asm volatile("s_waitcnt vmcnt(0)" ::: "memory");
        } else {
            XB_SPIN(xb_ld(&bar[XB_XGEN(b.x)]) == gen, bar);
            __builtin_amdgcn_fence(__ATOMIC_ACQUIRE, "agent");
            asm volatile("s_waitcnt vmcnt(0)" ::: "memory");
        }
    }
    __syncthreads();
}
constexpr int NWAVES = 8;
constexpr int BATCH = 16, SEQ = 2048, DM = 2048, DEPTH = 4, MEMLEN = 256;
constexpr int M = BATCH * SEQ;
constexpr int MM = BATCH * MEMLEN;
constexpr int NPROJ = 6144, INCOLS = 6150, DFF = 5632, CROSSW = 512;
constexpr int QA_C = 0, KA_C = 512, VA_C = 1024, QB_C = 1536, KB_C = 2304, VB_C = 3072, QC_C = 3840, KC_C = 4608, VC_C = 5376;
constexpr float EPS = 1e-6f;
constexpr int N_PHASES = 1 + 12 * DEPTH;
#ifndef PH_MASK
#define PH_MASK 0x1fff
#endif
#define EN(k) (((PH_MASK) >> (k)) & 1)
#ifndef ATTN_PIPE
#define ATTN_PIPE 1
#endif
#if ATTN_PIPE
#define ATTN_SM attn_unit_sm
#else
#define ATTN_SM attn_unit
#endif
#ifndef DUP_A0
#define DUP_A0 1
#endif
#ifndef DUP_A1
#define DUP_A1 1
#endif
#ifndef DUP_A2
#define DUP_A2 1
#endif
#ifndef CLASS_PIPE
#define CLASS_PIPE 1
#endif
#ifndef FFN_SPLIT
#define FFN_SPLIT 1
#endif
#ifndef NT_PROJ
#define NT_PROJ 1
#endif
#ifndef DUP_BAR
#define DUP_BAR 0
#endif
#ifndef DUP_T
#define DUP_T 1
#endif
#ifndef N_BARS
#define N_BARS 1
#endif
#ifndef DUP_A
#define DUP_A 1
#endif
#ifndef DUP_GEMM
#define DUP_GEMM 1
#endif
#ifndef DEFER_L
#define DEFER_L 0
#endif
#ifndef GEMM_SP2
#define GEMM_SP2 true
#endif
#ifndef GEMM_ALIGN
#define GEMM_ALIGN true
#endif
#ifndef EN_A0
#define EN_A0 1
#endif
#ifndef EN_A1
#define EN_A1 1
#endif
#ifndef EN_A2
#define EN_A2 1
#endif
#ifndef EN_G0
#define EN_G0 1
#endif
#ifndef ROPE_TILES
#define ROPE_TILES 4
#endif
#ifndef MK_ONE_LAUNCH
#define MK_ONE_LAUNCH 0
#endif

constexpr size_t MiB = 1u << 20;
constexpr size_t WS_CTL = 0, CTL_ZERO_BYTES = 1 * MiB;
constexpr size_t WS_ROPE = 1 * MiB;
constexpr size_t WS_LOGF = 9 * MiB;
constexpr size_t WS_RS = 9 * MiB + 768 * 1024;
constexpr size_t WS_KV = 10 * MiB;
constexpr size_t WS_W = 42 * MiB, W_LAYER = 102 * MiB;
constexpr size_t WO_IN = 0, WO_OUT = 24 * MiB, WO_CQ = 32 * MiB, WO_CO = 34 * MiB, WO_GU = 36 * MiB, WO_DN = 80 * MiB;
constexpr size_t WS_XB = 450 * MiB;
constexpr size_t WS_YB = 578 * MiB;
constexpr size_t WS_MEMN = WS_YB;
constexpr size_t WS_WCKV = 1090 * MiB;
constexpr size_t OUT_O = 0, OUT_OA = 128 * MiB;
constexpr size_t WS_BIG = 706 * MiB;
constexpr size_t WS_QX = WS_BIG, WS_O2 = WS_BIG + 32 * MiB;
constexpr size_t WS_END = 1106 * MiB;
constexpr int CW_TMO = 0, CW_BAR = 4096, CW_Q = 65536, CW_WDONE = 201000, CW_WFT = 98304  ;

constexpr int RING_BYTES = 131072, LDSCTL_OFF = RING_BYTES, MISC_OFF = LDSCTL_OFF + 320, LDS_BYTES = 147456;
static_assert(att::ATT_LDS_BYTES <= RING_BYTES, "attention scratch inside the ring region");

__device__ const double kInvFreq[32] = { 1.0, 0.7498942093324559, 0.5623413251903491, 0.4216965034285822, 0.31622776601683794, 0.23713737056616552, 0.1778279410038923, 0.1333521432163324,
    0.1, 0.07498942093324558, 0.05623413251903491, 0.042169650342858224, 0.03162277660168379, 0.023713737056616554, 0.01778279410038923, 0.01333521432163324,
    0.01, 0.007498942093324558, 0.005623413251903491, 0.004216965034285823, 0.0031622776601683794, 0.0023713737056616554, 0.0017782794100389228, 0.001333521432163324,
    0.001, 0.0007498942093324559, 0.0005623413251903491, 0.00042169650342858224, 0.00031622776601683794, 0.00023713737056616554, 0.00017782794100389227, 0.0001333521432163324 };

struct Args {
    const float* x; const float* mem; const int* pos;
    const float *g_mix_pre, *g_mix_post, *w_in, *b_f, *lam_q1, *lam_k1, *lam_q2, *lam_k2, *g_diff_sub, *g_sb_out, *g_fox_out, *w_out;
    const float *g_x_pre, *g_x_post, *g_mem, *w_cq, *w_ckv, *w_co, *g_ffn_pre, *g_ffn_post, *w_gate, *w_up, *w_down;
    float* out; unsigned char* ws; int ph_lo, ph_hi, li, pad;
};

typedef unsigned u32x2 __attribute__((ext_vector_type(2)));
struct Frame { LAS unsigned char* lds; int tid, lane, wave, vcu, G; int rw0, rwend, rwstride; };
#define PHASE_FENCE(F) do { int t_ = threadIdx.x; asm volatile("" : "+v"(t_)); (F).tid = t_; (F).lane = t_ & 63; } while (0)

__device__ __forceinline__ float wave_sum(float v) {
#define WS_DPP(ctl_) v += __builtin_bit_cast(float, __builtin_amdgcn_update_dpp(0, __builtin_bit_cast(int, v), (ctl_), 0xF, 0xF, true))
    WS_DPP(0xB1); WS_DPP(0x4E); WS_DPP(0x141); WS_DPP(0x140);
#undef WS_DPP
    const int vi = __builtin_bit_cast(int, v);
    const float r0 = __builtin_bit_cast(float, __builtin_amdgcn_readlane(vi, 0)), r1 = __builtin_bit_cast(float, __builtin_amdgcn_readlane(vi, 16));
    const float r2 = __builtin_bit_cast(float, __builtin_amdgcn_readlane(vi, 32)), r3 = __builtin_bit_cast(float, __builtin_amdgcn_readlane(vi, 48));
    return (r0 + r1) + (r2 + r3);
}
__device__ __forceinline__ unsigned pkbf(float lo, float hi) { return pg8::cvt_pk_bf16(lo, hi); }
__device__ __forceinline__ float bflo(unsigned w) { return __uint_as_float(w << 16); }
__device__ __forceinline__ float bfhi(unsigned w) { return __uint_as_float(w & 0xffff0000u); }

__device__ __forceinline__ void transpose_item(const float* W, int ld, int K, int k0, int scol, bf16* WT, int n0, LAS float* scr, int lane, const float* gain = nullptr) {
#pragma unroll
    for (int i = 0; i < 32; ++i) { const int kk = 2 * i + (lane >> 5); scr[kk * 33 + (lane & 31)] = W[(size_t)(k0 + kk) * ld + scol]; }
    LDS_WAIT(); asm volatile("" ::: "memory");
    const int c = lane & 7;
    f32x4 ga = {1.f, 1.f, 1.f, 1.f}, gb = {1.f, 1.f, 1.f, 1.f};
    if (gain) { ga = *(const GAS f32x4*)(gain + k0 + 8 * c); gb = *(const GAS f32x4*)(gain + k0 + 8 * c + 4); }
#pragma unroll
    for (int j = 0; j < 4; ++j) { const int n = (lane >> 3) + 8 * j; const LAS float* s = scr + (8 * c) * 33 + n;
        v4u o; o.x = pkbf(s[0 * 33] * ga.x, s[1 * 33] * ga.y); o.y = pkbf(s[2 * 33] * ga.z, s[3 * 33] * ga.w); o.z = pkbf(s[4 * 33] * gb.x, s[5 * 33] * gb.y); o.w = pkbf(s[6 * 33] * gb.z, s[7 * 33] * gb.w);
        *(GAS v4u*)(WT + (size_t)(n0 + n) * K + k0 + 8 * c) = o; }
    LDS_WAIT(); asm volatile("" ::: "memory");
}
__device__ __forceinline__ void p0_weights(Frame& F, const Args& a, unsigned char* ws, int gw, int NGW, int l0, int l1, int ckv) {
    LAS float* scr = (LAS float*)(F.lds + F.wave * 16384);
    const int j = F.lane & 31;
    constexpr int I_IN = 32 * 192, I_OUT = 32 * 64, I_CQ = 32 * 16, I_CKV = 32 * 32, I_CO = 8 * 64, I_GU = 32 * 352, I_DN = 88 * 64;
    constexpr int I_LAYER = I_IN + I_OUT + I_CQ + I_CKV + I_CO + I_GU + I_DN;
    for (int it = l0 * I_LAYER + gw; it < l1 * I_LAYER; it += NGW) {
        const int l = it / I_LAYER; int r = it - l * I_LAYER;
        { const bool is_ckv = r >= I_IN + I_OUT + I_CQ && r < I_IN + I_OUT + I_CQ + I_CKV, is_in = r < I_IN;
          if ((ckv == 1 && is_ckv) || (ckv == 2 && !is_ckv) || (ckv == 3 && !(is_ckv || is_in)) || (ckv == 4 && (is_ckv || is_in))) continue; }
        unsigned char* wl = ws + WS_W + (size_t)l * W_LAYER;
        if (r < I_IN) { const int kb = r / 192, nb = r % 192, n = 32 * nb + j; int sc = n; if (n < 1024) { const int p = n & 63; sc = (n & ~63) + (p >> 1) + 32 * (p & 1); }
            transpose_item(a.w_in + (size_t)l * DM * INCOLS, INCOLS, DM, 64 * kb, sc, (bf16*)(wl + WO_IN), 32 * nb, scr, F.lane, a.g_mix_pre + l * DM); continue; } r -= I_IN;
        if (r < I_OUT) { const int kb = r / 64, nb = r % 64; transpose_item(a.w_out + (size_t)l * DM * DM, DM, DM, 64 * kb, 32 * nb + j, (bf16*)(wl + WO_OUT), 32 * nb, scr, F.lane); continue; } r -= I_OUT;
        if (r < I_CQ) { const int kb = r / 16, nb = r % 16; transpose_item(a.w_cq + (size_t)l * DM * CROSSW, CROSSW, DM, 64 * kb, 32 * nb + j, (bf16*)(wl + WO_CQ), 32 * nb, scr, F.lane, a.g_x_pre + l * DM); continue; } r -= I_CQ;
        if (r < I_CKV) { const int kb = r / 32, nb = r % 32; transpose_item(a.w_ckv + (size_t)l * DM * 1024, 1024, DM, 64 * kb, 32 * nb + j, (bf16*)(ws + WS_WCKV) + (size_t)l * 1024 * DM, 32 * nb, scr, F.lane); continue; } r -= I_CKV;
        if (r < I_CO) { const int kb = r / 64, nb = r % 64; transpose_item(a.w_co + (size_t)l * CROSSW * DM, DM, CROSSW, 64 * kb, 32 * nb + j, (bf16*)(wl + WO_CO), 32 * nb, scr, F.lane); continue; } r -= I_CO;
        if (r < I_GU) { const int kb = r / 352, nb = r % 352, n = 32 * nb + j, pn = n >> 8, rr = n & 255; const float* src = (rr < 128 ? a.w_gate : a.w_up) + (size_t)l * DM * DFF;
            transpose_item(src, DFF, DM, 64 * kb, 128 * pn + (rr & 127), (bf16*)(wl + WO_GU), 32 * nb, scr, F.lane, a.g_ffn_pre + l * DM); continue; } r -= I_GU;
        { const int kb = r / 64, nb = r % 64; transpose_item(a.w_down + (size_t)l * DFF * DM, DM, DFF, 64 * kb, 32 * nb + j, (bf16*)(wl + WO_DN), 32 * nb, scr, F.lane); }
    }
}
__device__ __forceinline__ void p0_rope(Frame& F, const Args& a, unsigned char* ws) {
    float* tab = (float*)(ws + WS_ROPE);
    const int gt = (F.vcu * NWAVES + F.wave) * 64 + F.lane, NT = F.G * NWAVES * 64;
    for (int e = gt; e < M * 32; e += NT) { const int m = e >> 5, i = e & 31;
        const double ang = (double)a.pos[m] * kInvFreq[i]; const double rev = ang * 0.15915494309189535; const double fr = rev - __builtin_floor(rev);
        const float frf = (float)fr;
        tab[(size_t)e * 2] = __builtin_amdgcn_cosf(frf); tab[(size_t)e * 2 + 1] = __builtin_amdgcn_sinf(frf); }
}
__device__ __forceinline__ void p0_memn(Frame& F, const Args& a, unsigned char* ws, int ncl) {
    const int gw = F.vcu * NWAVES + F.wave, NGW = F.G * NWAVES, mpc = MM / ncl;
    for (int r = gw; r < MM; r += NGW) { const int c = r / mpc, rl = r - c * mpc;
        const GAS f32x4* xr = (const GAS f32x4*)(a.mem + (size_t)r * DM) + F.lane;
        f32x4 v[8]; float s = 0.f;
#pragma unroll
        for (int j = 0; j < 8; ++j) { v[j] = xr[64 * j]; s += (v[j].x * v[j].x + v[j].y * v[j].y) + (v[j].z * v[j].z + v[j].w * v[j].w); }
        const float rstd = 1.f / sqrtf(wave_sum(s) * (1.f / DM) + EPS);
#pragma unroll
        for (int j = 0; j < 8; ++j) v[j] = v[j] * rstd;
        for (int l = 0; l < DEPTH; ++l) { const GAS f32x4* gr = (const GAS f32x4*)(a.g_mem + (size_t)l * DM) + F.lane;
            const size_t drow = (size_t)c * (M / ncl) + (size_t)l * mpc + rl;
            GAS unsigned long long* o8 = (GAS unsigned long long*)((bf16*)(ws + WS_MEMN) + drow * DM) + F.lane;
#pragma unroll
            for (int j = 0; j < 8; ++j) { const f32x4 g = gr[64 * j]; o8[64 * j] = (unsigned long long)pkbf(v[j].x * g.x, v[j].y * g.y) | ((unsigned long long)pkbf(v[j].z * g.z, v[j].w * g.w) << 32); } }
    }
}
template <bool FINAL>
__device__ __forceinline__ float row_update(int lane, int m, const bf16* y, const f32x4 (&gp)[8], const float* xin, const bf16* xb, bf16* xbo, float* rs, float* outf, f32x4 (&v)[8]) {
    if (xin) { const GAS f32x4* xr = (const GAS f32x4*)(xin + (size_t)m * DM) + lane;
#pragma unroll
        for (int j = 0; j < 8; ++j) v[j] = xr[64 * j];
    } else { const GAS u32x2* xr = (const GAS u32x2*)(xb + (size_t)m * DM) + lane;
#pragma unroll
        for (int j = 0; j < 8; ++j) { const u32x2 w = xr[64 * j]; v[j] = (f32x4){bflo(w.x), bfhi(w.x), bflo(w.y), bfhi(w.y)}; } }
    if (y) {
        const GAS u32x2* yr = (const GAS u32x2*)(y + (size_t)m * DM) + lane; f32x4 yv[8]; float s = 0.f;
#pragma unroll
        for (int j = 0; j < 8; ++j) { const u32x2 w = yr[64 * j]; yv[j] = (f32x4){bflo(w.x), bfhi(w.x), bflo(w.y), bfhi(w.y)}; s += (yv[j].x * yv[j].x + yv[j].y * yv[j].y) + (yv[j].z * yv[j].z + yv[j].w * yv[j].w); }
        const float rstd = 1.f / sqrtf(wave_sum(s) * (1.f / DM) + EPS);
#pragma unroll
        for (int j = 0; j < 8; ++j) v[j] = v[j] + yv[j] * rstd * gp[j];
    }
    if constexpr (FINAL) {
        GAS f32x4* xo = (GAS f32x4*)(outf + (size_t)m * DM) + lane;
#pragma unroll
        for (int j = 0; j < 8; ++j) xo[64 * j] = v[j];
        return 0.f;
    } else {
        GAS u32x2* o8 = (GAS u32x2*)(xbo + (size_t)m * DM) + lane; float s = 0.f;
#pragma unroll
        for (int j = 0; j < 8; ++j) { o8[64 * j] = (u32x2){pkbf(v[j].x, v[j].y), pkbf(v[j].z, v[j].w)}; s += (v[j].x * v[j].x + v[j].y * v[j].y) + (v[j].z * v[j].z + v[j].w * v[j].w); }
        const float rstd = 1.f / sqrtf(wave_sum(s) * (1.f / DM) + EPS);
        if (lane == 0) rs[m] = rstd;
        return rstd;
    }
}
__device__ __forceinline__ void fc_store(int lane, int m, float t, float rstd, const float* bfv, float* logf) {
    if (lane < 6) {
        const float z = t * rstd + bfv[lane];
        const float ls = fminf(z, 0.f) - 0.6931471805599453f * __builtin_amdgcn_logf(1.0f + __builtin_amdgcn_exp2f(-1.4426950408889634f * fabsf(z)));
        const int b = m / SEQ, s_ = m - b * SEQ; logf[((size_t)b * 6 + lane) * SEQ + s_] = ls; }
}
template <bool FC, bool FINAL>
__device__ __forceinline__ void row_phase(Frame& F, const bf16* y, const float* gpost, const float* xin, const bf16* xb, bf16* xbo, float* rs, float* outf,
                                          const float* wfc_src  , const float* gfc, const float* bfv, float* logf, const float* wfc_tab = nullptr  ) {
    const int gw = F.rw0, NGW = F.rwstride, MEND = F.rwend;
    LAS float* wfc = (LAS float*)F.lds;
    if constexpr (FC) {
        if (wfc_tab) { for (int e = F.tid; e < 6 * DM / 4; e += NWAVES * 64) ((LAS f32x4*)wfc)[e] = ((const GAS f32x4*)wfc_tab)[e]; }
        else
        for (int e = F.tid; e < 6 * DM; e += NWAVES * 64) { const int k = e / 6, jj = e - 6 * k; wfc[jj * DM + k] = wfc_src[(size_t)k * INCOLS + NPROJ + jj] * gfc[k]; }
        __syncthreads();
    }
    f32x4 gp[8];
#pragma unroll
    for (int j = 0; j < 8; ++j) gp[j] = y ? ((const GAS f32x4*)gpost)[F.lane + 64 * j] : (f32x4){0.f, 0.f, 0.f, 0.f};
    if constexpr (FC) {
        for (int m = gw; m < MEND; m += 2 * NGW) {
            const int m1 = m + NGW; f32x4 v0[8], v1[8];
            const float r0 = row_update<false>(F.lane, m, y, gp, xin, xb, xbo, rs, outf, v0);
            const bool two = m1 < MEND; float r1 = 0.f;
#pragma unroll
            for (int j = 0; j < 8; ++j) v1[j] = (f32x4){0.f, 0.f, 0.f, 0.f};
            if (two) r1 = row_update<false>(F.lane, m1, y, gp, xin, xb, xbo, rs, outf, v1);
            float ta = 0.f, tb = 0.f;
#pragma unroll
            for (int jj = 0; jj < 6; ++jj) { pg8::f32x2 a0 = {0.f, 0.f}, a1 = {0.f, 0.f};
#pragma unroll
                for (int j = 0; j < 8; ++j) { const f32x4 w = *(const LAS f32x4*)(wfc + jj * DM + 4 * F.lane + 256 * j);
                    const pg8::f32x2 wl = {w.x, w.y}, wh = {w.z, w.w};
                    a0 += (pg8::f32x2){v0[j].x, v0[j].y} * wl; a0 += (pg8::f32x2){v0[j].z, v0[j].w} * wh; a1 += (pg8::f32x2){v1[j].x, v1[j].y} * wl; a1 += (pg8::f32x2){v1[j].z, v1[j].w} * wh; }
                const float sa = wave_sum(a0.x + a0.y), sb = wave_sum(a1.x + a1.y); ta = (F.lane == jj) ? sa : ta; tb = (F.lane == jj) ? sb : tb; }
            fc_store(F.lane, m, ta, r0, bfv, logf);
            if (two) fc_store(F.lane, m1, tb, r1, bfv, logf);
        }
        __syncthreads();
    } else {
        for (int m = gw; m < MEND; m += NGW) { f32x4 v[8]; (void)row_update<FINAL>(F.lane, m, y, gp, xin, xb, xbo, rs, outf, v); }
    }
}
__device__ __forceinline__ void subnorm_phase(Frame& F, const Args& a, int l, const bf16* OA, bf16* HB) {
    const int gw = F.rw0, NGW = F.rwstride, MEND = F.rwend, lane = F.lane;
    const float d1 = wave_sum(a.lam_q1[l * 64 + lane] * a.lam_k1[l * 64 + lane]), d2 = wave_sum(a.lam_q2[l * 64 + lane] * a.lam_k2[l * 64 + lane]);
    const float lam_init = 0.8f - 0.6f * expf(-0.3f * (float)l);
    const float lam = (expf(d1) - expf(d2)) + lam_init, post = 1.0f - lam_init;
    const int hd = lane >> 4, c8 = (lane & 15) * 8;
    f32x4 gd0 = *(const GAS f32x4*)(a.g_diff_sub + l * 128 + c8), gd1 = *(const GAS f32x4*)(a.g_diff_sub + l * 128 + c8 + 4);
    f32x4 gs[3], gf[3];
#pragma unroll
    for (int j = 0; j < 3; ++j) { gs[j] = *(const GAS f32x4*)(a.g_sb_out + l * 768 + 4 * lane + 256 * j); gf[j] = *(const GAS f32x4*)(a.g_fox_out + l * 768 + 4 * lane + 256 * j); }
    for (int m0 = gw; m0 < MEND; m0 += 2 * NGW) {
        const int m1 = m0 + NGW; const bool two = m1 < MEND; const int mb = two ? m1 : m0;
        v4u w1_[2], w2_[2]; u32x2 sb_[2][3], fx_[2][3];
#pragma unroll
        for (int h = 0; h < 2; ++h) { const int mm = h ? mb : m0; const bf16* hq = HB + (size_t)mm * DM;
            w1_[h] = *(const GAS v4u*)(OA + (size_t)mm * 1024 + hd * 256 + c8); w2_[h] = *(const GAS v4u*)(OA + (size_t)mm * 1024 + hd * 256 + 128 + c8);
#pragma unroll
            for (int j = 0; j < 3; ++j) { sb_[h][j] = *(const GAS u32x2*)(hq + 512 + 4 * lane + 256 * j); fx_[h][j] = *(const GAS u32x2*)(hq + 1280 + 4 * lane + 256 * j); } }
#pragma unroll
        for (int h = 0; h < 2; ++h) { if (h == 1 && !two) break; const int m = h ? m1 : m0; const v4u w1 = w1_[h], w2 = w2_[h];
        bf16* hr = HB + (size_t)m * DM;
        u32x2 sb[3], fx[3];
#pragma unroll
        for (int j = 0; j < 3; ++j) { sb[j] = sb_[h][j]; fx[j] = fx_[h][j]; }
        float d[8];
        d[0] = bflo(w1.x) - lam * bflo(w2.x); d[1] = bfhi(w1.x) - lam * bfhi(w2.x); d[2] = bflo(w1.y) - lam * bflo(w2.y); d[3] = bfhi(w1.y) - lam * bfhi(w2.y);
        d[4] = bflo(w1.z) - lam * bflo(w2.z); d[5] = bfhi(w1.z) - lam * bfhi(w2.z); d[6] = bflo(w1.w) - lam * bflo(w2.w); d[7] = bfhi(w1.w) - lam * bfhi(w2.w);
        float s = 0.f;
#pragma unroll
        for (int k = 0; k < 8; ++k) s += d[k] * d[k];
#define SN_DPP(ctl_) s += __builtin_bit_cast(float, __builtin_amdgcn_update_dpp(0, __builtin_bit_cast(int, s), (ctl_), 0xF, 0xF, true))
        SN_DPP(0xB1); SN_DPP(0x4E); SN_DPP(0x141); SN_DPP(0x140);
#undef SN_DPP
        const float rd = post / sqrtf(s * (1.f / 128.f) + EPS);
        v4u od; od.x = pkbf(d[0] * rd * gd0.x, d[1] * rd * gd0.y); od.y = pkbf(d[2] * rd * gd0.z, d[3] * rd * gd0.w); od.z = pkbf(d[4] * rd * gd1.x, d[5] * rd * gd1.y); od.w = pkbf(d[6] * rd * gd1.z, d[7] * rd * gd1.w);
        *(GAS v4u*)(hr + hd * 128 + c8) = od;
        float ss = 0.f, sf = 0.f; f32x4 vs[3], vf[3];
#pragma unroll
        for (int j = 0; j < 3; ++j) { vs[j] = (f32x4){bflo(sb[j].x), bfhi(sb[j].x), bflo(sb[j].y), bfhi(sb[j].y)}; vf[j] = (f32x4){bflo(fx[j].x), bfhi(fx[j].x), bflo(fx[j].y), bfhi(fx[j].y)};
            ss += (vs[j].x * vs[j].x + vs[j].y * vs[j].y) + (vs[j].z * vs[j].z + vs[j].w * vs[j].w); sf += (vf[j].x * vf[j].x + vf[j].y * vf[j].y) + (vf[j].z * vf[j].z + vf[j].w * vf[j].w); }
        const float rs = 1.f / sqrtf(wave_sum(ss) * (1.f / 768.f) + EPS), rf = 1.f / sqrtf(wave_sum(sf) * (1.f / 768.f) + EPS);
#pragma unroll
        for (int j = 0; j < 3; ++j) { const f32x4 u = vs[j] * rs * gs[j], w = vf[j] * rf * gf[j];
            *(GAS u32x2*)(hr + 512 + 4 * lane + 256 * j) = (u32x2){pkbf(u.x, u.y), pkbf(u.z, u.w)}; *(GAS u32x2*)(hr + 1280 + 4 * lane + 256 * j) = (u32x2){pkbf(w.x, w.y), pkbf(w.z, w.w)}; }
        }
    }
}
__device__ __forceinline__ unsigned claim_issue(Frame& F, gu32* ctr) {
    unsigned v = 0u;
    if (F.tid == 0) v = __hip_atomic_fetch_add(ctr, 1u, __ATOMIC_RELAXED, __HIP_MEMORY_SCOPE_AGENT);
    return v;
}
__device__ __forceinline__ int claim_publish(Frame& F, unsigned v) {
    LAS unsigned* slot = (LAS unsigned*)(F.lds + att::OFF_MISC);
    if (F.tid == 0) *slot = v;
    __syncthreads();
    const int r = (int)*slot;
    __syncthreads();
    return r;
}
__global__ void __launch_bounds__(NWAVES * 64, 2) trunk_fwd(Args args) {
    extern __shared__ __attribute__((aligned(16))) unsigned char lds[];
    Frame F;
    F.lds = (LAS unsigned char*)lds;
    F.tid = threadIdx.x; F.lane = F.tid & 63; F.wave = __builtin_amdgcn_readfirstlane(F.tid >> 6);
    F.G = gridDim.x; { const int bx = blockIdx.x; F.vcu = (F.G % 8 == 0) ? (bx % 8) * (F.G / 8) + bx / 8 : bx; }
    unsigned char* ws = args.ws;
    gu32* ctl = (gu32*)(ws + WS_CTL);
    volatile LAS unsigned* MISC = (volatile LAS unsigned*)(F.lds + MISC_OFF);
    for (int u = F.tid; u < (LDS_BYTES - LDSCTL_OFF) / 4; u += NWAVES * 64) ((LAS unsigned*)(F.lds + LDSCTL_OFF))[u] = 0u;
    __syncthreads();
    const int ncl = (CLASS_PIPE && F.G % 8 == 0) ? 8 : 1, xc = (ncl == 8) ? ((int)blockIdx.x & 7) : 0, rk = (ncl == 8) ? ((int)blockIdx.x >> 3) : (int)blockIdx.x, NC = F.G / ncl;
    const int crows = M / ncl, crow0 = xc * crows, bpc = BATCH / ncl, mpc = MM / ncl;
    const int dfl = (ncl == 8 && args.ph_lo == 0 && args.ph_hi == N_PHASES) ? DEFER_L : DEPTH;
    XcdBarrier bar; bar.bar = (unsigned*)(ctl + CW_BAR); bar.x = 0; bar.st = nullptr; bar.npart = 0u;
    XcdBarrier cbar = bar;
    const int lo = args.ph_lo, hi = args.ph_hi;
    if (hi - lo > 1) { bar = xcd_barrier_post((unsigned*)(ctl + CW_BAR), MISC + 8);
        cbar = (ncl == 8) ? xcd_barrier_post((unsigned*)(ctl + CW_BAR) + (1 + xc) * XCD_BAR_WORDS, MISC + 10, (unsigned)NC) : bar; }
#define SET_ROWS_GLOBAL() do { F.rw0 = F.vcu * NWAVES + F.wave; F.rwend = M; F.rwstride = F.G * NWAVES; } while (0)
#define SET_ROWS_CLASS()  do { F.rw0 = crow0 + rk * NWAVES + F.wave; F.rwend = crow0 + crows; F.rwstride = NC * NWAVES; } while (0)
#define CLASS_BAR() xcd_barrier(cbar)
#define GRID_BAR() xcd_barrier(bar)
#define IN(k) (lo <= (k) && (k) < hi)
#define BOTH(k) (IN(k) && IN((k) + 1))
#define ALDS ((__attribute__((address_space(3))) char*)F.lds)
    bf16* XB = (bf16*)(ws + WS_XB); bf16* YB = (bf16*)(ws + WS_YB); bf16* PROJ = (bf16*)(ws + WS_BIG); float* RS = (float*)(ws + WS_RS);
    float* LOGF = (float*)(ws + WS_LOGF); const float* ROPE = (const float*)(ws + WS_ROPE);
    bf16* XBc = XB + (size_t)crow0 * DM; bf16* YBc = YB + (size_t)crow0 * DM; bf16* PROJc = PROJ + (size_t)crow0 * NPROJ; float* RSc = RS + crow0; const float* ROPEc = ROPE + (size_t)crow0 * 64;
    bf16* BIGc = PROJc;
    bf16* HIDc = BIGc; bf16* QXc = BIGc; bf16* O2c = BIGc + (size_t)crows * CROSSW;
    bf16* QXv = QXc - (size_t)crow0 * CROSSW; bf16* O2v = O2c - (size_t)crow0 * CROSSW;
    bf16* HBc = (bf16*)((unsigned char*)args.out + (size_t)crow0 * DM * 4); bf16* OAc = HBc + (size_t)crows * DM;
    bf16* HBv = HBc - (size_t)crow0 * DM; bf16* OAv = OAc - (size_t)crow0 * 1024;
    const bf16* MEMNc = (const bf16*)(ws + WS_MEMN) + (size_t)crow0 * DM;
    bf16* KVc = (bf16*)(ws + WS_KV) + (size_t)xc * DEPTH * mpc * 1024;

    if (EN(0) && IN(0)) { PHASE_FENCE(F);
        { const int gw_ = F.vcu * NWAVES + F.wave, ngw_ = F.G * NWAVES;
          if (dfl == 0) { p0_weights(F, args, ws, gw_, ngw_, 0, 1, 3); p0_weights(F, args, ws, gw_, ngw_, 1, DEPTH, 2); }
          else { p0_weights(F, args, ws, gw_, ngw_, 0, dfl, 0); if (dfl < DEPTH) p0_weights(F, args, ws, gw_, ngw_, dfl, DEPTH, 2); } }
        p0_rope(F, args, ws);
        { float* wft_ = (float*)(ctl + CW_WFT);
          for (int e = F.vcu * (NWAVES * 64) + F.tid; e < (DEPTH - 1) * 6 * DM; e += F.G * NWAVES * 64) { const int l1 = e / (6 * DM), r_ = e - l1 * 6 * DM, jj = r_ / DM, k = r_ - jj * DM;
              wft_[e] = args.w_in[(size_t)(l1 + 1) * DM * INCOLS + (size_t)k * INCOLS + NPROJ + jj] * args.g_mix_pre[(l1 + 1) * DM + k]; } }
        p0_memn(F, args, ws, ncl);
        __syncthreads();
        SET_ROWS_GLOBAL();
        row_phase<true, false>(F, nullptr, nullptr, args.x, XB, XB, RS, nullptr, args.w_in, args.g_mix_pre, args.b_f, LOGF);
        if (BOTH(0)) GRID_BAR();
    }
    if (dfl < DEPTH && (xc & 1) == 0) {
        PHASE_FENCE(F);
        { const int gw_ = (((xc >> 1) * NC + rk) * NWAVES) + F.wave, ngw_ = 4 * NC * NWAVES;
          if (dfl == 0) { p0_weights(F, args, ws, gw_, ngw_, 0, 1, 4); p0_weights(F, args, ws, gw_, ngw_, 1, DEPTH, 1); }
          else p0_weights(F, args, ws, gw_, ngw_, dfl, DEPTH, 1); }
        asm volatile("s_waitcnt vmcnt(0)" ::: "memory");
        __syncthreads();
        if (F.tid == 0) { __builtin_amdgcn_fence(__ATOMIC_RELEASE, "agent"); asm volatile("s_waitcnt vmcnt(0)" ::: "memory");
                          (void)__hip_atomic_fetch_add((unsigned*)(ctl + CW_WDONE), 1u, __ATOMIC_RELAXED, __HIP_MEMORY_SCOPE_AGENT); }
        __syncthreads();
    }
    SET_ROWS_CLASS();
#define WAIT_DEFERRED() do { if (F.tid == 0) { unsigned sp_ = 0u; while (__hip_atomic_load((unsigned*)(ctl + CW_WDONE), __ATOMIC_RELAXED, __HIP_MEMORY_SCOPE_AGENT) < (unsigned)(4 * NC)) { __builtin_amdgcn_s_sleep(8); if (++sp_ > (1u << 24)) break; } \
                                     __builtin_amdgcn_fence(__ATOMIC_ACQUIRE, "agent"); asm volatile("s_waitcnt vmcnt(0)" ::: "memory"); } \
                             __syncthreads(); } while (0)
#if defined(DEPHASE_US)
    if (hi - lo > 1) { if (F.tid == 0) { const unsigned long long t0 = __builtin_amdgcn_s_memrealtime(); while (__builtin_amdgcn_s_memrealtime() - t0 < (unsigned long long)(xc * DEPHASE_US * 100)) __builtin_amdgcn_s_sleep(8); } __syncthreads(); }
#endif
    for (int l = 0; l < DEPTH; ++l) {
        const int pb = 1 + 12 * l;
        unsigned char* wl = ws + WS_W + (size_t)l * W_LAYER;
        if (EN(1) && IN(pb + 0)) { PHASE_FENCE(F);
            if (l == dfl && dfl > 0 && dfl < DEPTH) WAIT_DEFERRED();
            if (EN_G0 && l == 0) { pg8::Gemm g{MEMNc, (const bf16*)(ws + WS_WCKV), DEPTH * mpc, DEPTH * 1024, DM}; pg8::KvOrder S{mpc / 256, NC, rk};
                pg8::EpiStore E{KVc, 1024, nullptr, 0, 3, nullptr}; pg8::gemm_phase<pg8::EpiStore, pg8::KvOrder, GEMM_ALIGN, GEMM_SP2>(F.lds, g, S, E); }
            pg8::Gemm g{XBc, (const bf16*)(wl + WO_IN), crows, NPROJ, DM}; pg8::ClassOrder S; S.init(crows, NPROJ, NC, rk);
            pg8::EpiStore E{PROJc, NPROJ, ROPEc, ROPE_TILES, -1, RSc}; pg8::gemm_phase<pg8::EpiStore, pg8::ClassOrder, GEMM_ALIGN, GEMM_SP2>(F.lds, g, S, E);
            if (BOTH(pb + 0)) CLASS_BAR();
        }
        if (EN(2) && IN(pb + 1)) { PHASE_FENCE(F);
            const int nbh = bpc * 6, nbv = bpc * 8;
            gu32* q0 = ctl + CW_Q + 64 * ((3 * l) * 8 + xc);
            { gu32* qc_ = q0; unsigned pend_ = claim_issue(F, qc_); for (int u = claim_publish(F, pend_); u < 8 * nbh; u = claim_publish(F, pend_)) { pend_ = claim_issue(F, qc_); const int qb = 7 - u / nbh, bh = xc * nbh + u % nbh, b = bh / 6, h = bh % 6;
                const size_t r0 = (size_t)b * SEQ; const int pos0 = qb * 256;
#if SB_RING
                att::attn_unit_sb4(PROJ + (r0 + pos0) * NPROJ + QB_C + h * 128, NPROJ, PROJ + r0 * NPROJ + KB_C + h * 128, PROJ + r0 * NPROJ + VB_C + h * 128, NPROJ,
                                  HBv + (r0 + pos0) * DM + 512 + h * 128, DM, pos0, 4 * (qb + 1), ALDS); } }
#else
                att::attn_unit<1>(PROJ + (r0 + pos0) * NPROJ + QB_C + h * 128, NPROJ, PROJ + r0 * NPROJ + KB_C + h * 128, PROJ + r0 * NPROJ + VB_C + h * 128, NPROJ,
                                  HBv + (r0 + pos0) * DM + 512 + h * 128, DM, pos0, 4 * (qb + 1), 0, nullptr, ALDS); } }
#endif
            { gu32* qc_ = q0 + 64 * 8; unsigned pend_ = claim_issue(F, qc_); for (int u = claim_publish(F, pend_); u < 8 * nbh; u = claim_publish(F, pend_)) { pend_ = claim_issue(F, qc_); const int qb = 7 - u / nbh, bh = xc * nbh + u % nbh, b = bh / 6, h = bh % 6;
                const size_t r0 = (size_t)b * SEQ; const int pos0 = qb * 256;
                att::ATTN_SM<2>(PROJ + (r0 + pos0) * NPROJ + QC_C + h * 128, NPROJ, PROJ + r0 * NPROJ + KC_C + h * 128, PROJ + r0 * NPROJ + VC_C + h * 128, NPROJ,
                                  HBv + (r0 + pos0) * DM + 1280 + h * 128, DM, pos0, 4 * (qb + 1), 0, LOGF + (size_t)bh * SEQ, ALDS); } }
            { gu32* qc_ = q0 + 64 * 16; unsigned pend_ = claim_issue(F, qc_); for (int u = claim_publish(F, pend_); u < 8 * nbv; u = claim_publish(F, pend_)) { pend_ = claim_issue(F, qc_); const int qb = 7 - u / nbv, bv = xc * nbv + u % nbv, b = bv / 8, vh = bv % 8, h = vh >> 1, jm = vh & 1;
                const size_t r0 = (size_t)b * SEQ; const int pos0 = qb * 256;
                att::ATTN_SM<0>(PROJ + (r0 + pos0) * NPROJ + QA_C + h * 128 + jm * 64, NPROJ, PROJ + r0 * NPROJ + KA_C + h * 128, PROJ + r0 * NPROJ + VA_C + h * 128, NPROJ,
                                  OAv + (r0 + pos0) * 1024 + vh * 128, 1024, pos0, 4 * (qb + 1), jm * 128, nullptr, ALDS); } }
            if (BOTH(pb + 1)) CLASS_BAR();
        }
        if (EN(3) && IN(pb + 2)) { PHASE_FENCE(F); subnorm_phase(F, args, l, OAv, HBv); if (BOTH(pb + 2)) CLASS_BAR(); }
        if (EN(4) && IN(pb + 3)) { PHASE_FENCE(F);
            if (l == 0 && dfl == 0) WAIT_DEFERRED();
            pg8::Gemm g{HBc, (const bf16*)(wl + WO_OUT), crows, DM, DM}; pg8::ClassOrder S; S.init(crows, DM, NC, rk);
            pg8::EpiStore E{YBc, DM, nullptr, 0, -1, nullptr}; pg8::gemm_phase<pg8::EpiStore, pg8::ClassOrder, GEMM_ALIGN, GEMM_SP2>(F.lds, g, S, E);
            if (BOTH(pb + 3)) CLASS_BAR();
        }
        if (EN(5) && IN(pb + 4)) { PHASE_FENCE(F);
            row_phase<false, false>(F, YB, args.g_mix_post + l * DM, nullptr, XB, XB, RS, nullptr, nullptr, nullptr, nullptr, nullptr); if (BOTH(pb + 4)) CLASS_BAR(); }
        if (EN(6) && IN(pb + 5)) { PHASE_FENCE(F);
            pg8::Gemm g{XBc, (const bf16*)(wl + WO_CQ), crows, CROSSW, DM}; pg8::ClassOrder S; S.init(crows, CROSSW, NC, rk);
            pg8::EpiStore E{QXc, CROSSW, nullptr, 0, -1, RSc}; pg8::gemm_phase<pg8::EpiStore, pg8::ClassOrder, GEMM_ALIGN, GEMM_SP2>(F.lds, g, S, E);
            if (BOTH(pb + 5)) CLASS_BAR();
        }
        if (EN(7) && IN(pb + 6)) { PHASE_FENCE(F);
            const bf16* kvl = KVc + (size_t)l * mpc * 1024;
            for (int u = (bpc * 4 * 8 * rk) / NC, ue_ = (bpc * 4 * 8 * (rk + 1)) / NC; u < ue_; ++u) { const int qb = u & 7, bh = u >> 3, lb = bh >> 2, h = bh & 3;   const size_t r0 = (size_t)(xc * bpc + lb) * SEQ + qb * 256;
                att::ATTN_SM<3>(QXv + r0 * CROSSW + h * 128, CROSSW, kvl + (size_t)lb * MEMLEN * 1024 + h * 128, kvl + (size_t)lb * MEMLEN * 1024 + 512 + h * 128, 1024,
                                  O2v + r0 * CROSSW + h * 128, CROSSW, 0, 4, 0, nullptr, ALDS); }
            if (BOTH(pb + 6)) CLASS_BAR();
        }
        if (EN(8) && IN(pb + 7)) { PHASE_FENCE(F);
            pg8::Gemm g{O2c, (const bf16*)(wl + WO_CO), crows, DM, CROSSW}; pg8::ClassOrder S; S.init(crows, DM, NC, rk);
            pg8::EpiStore E{YBc, DM, nullptr, 0, -1, nullptr}; pg8::gemm_phase<pg8::EpiStore, pg8::ClassOrder, GEMM_ALIGN, GEMM_SP2>(F.lds, g, S, E);
            if (BOTH(pb + 7)) CLASS_BAR();
        }
        if (EN(9) && IN(pb + 8)) { PHASE_FENCE(F);
            row_phase<false, false>(F, YB, args.g_x_post + l * DM, nullptr, XB, XB, RS, nullptr, nullptr, nullptr, nullptr, nullptr); if (BOTH(pb + 8)) CLASS_BAR(); }
        if (EN(10) && IN(pb + 9)) { PHASE_FENCE(F);
            pg8::Gemm g{XBc, (const bf16*)(wl + WO_GU), crows, 2 * DFF, DM}; pg8::ClassOrder S; S.init(crows, 2 * DFF, NC, rk);
            pg8::EpiSwiGLU E{HIDc, DFF, RSc}; pg8::gemm_phase<pg8::EpiSwiGLU, pg8::ClassOrder, GEMM_ALIGN, GEMM_SP2>(F.lds, g, S, E);
            if (BOTH(pb + 9)) CLASS_BAR();
        }
        if (EN(11) && IN(pb + 10)) { PHASE_FENCE(F);
            pg8::Gemm g{HIDc, (const bf16*)(wl + WO_DN), crows, DM, DFF}; pg8::ClassOrder S; S.init(crows, DM, NC, rk);
            pg8::EpiStore E{YBc, DM, nullptr, 0, -1, nullptr}; pg8::gemm_phase<pg8::EpiStore, pg8::ClassOrder, GEMM_ALIGN, GEMM_SP2>(F.lds, g, S, E);
            if (BOTH(pb + 10)) CLASS_BAR();
        }
        if (EN(12) && IN(pb + 11)) { PHASE_FENCE(F);
            if (l + 1 < DEPTH) row_phase<true, false>(F, YB, args.g_ffn_post + l * DM, nullptr, XB, XB, RS, nullptr, args.w_in + (size_t)(l + 1) * DM * INCOLS, args.g_mix_pre + (l + 1) * DM, args.b_f + (l + 1) * 6, LOGF, (const float*)(ctl + CW_WFT) + (size_t)l * 6 * DM);
            else row_phase<false, true>(F, YB, args.g_ffn_post + l * DM, nullptr, XB, XB, nullptr, args.out, nullptr, nullptr, nullptr, nullptr);
            if (BOTH(pb + 11)) CLASS_BAR();
        }
    }
#undef WAIT_DEFERRED
#undef IN
#undef BOTH
#undef GRID_BAR
#undef CLASS_BAR
#undef SET_ROWS_GLOBAL
#undef SET_ROWS_CLASS
#undef ALDS
}

extern "C" void kernel_launch(void* const* d_in, const int* in_sizes, int n_in, void* d_out, int out_size, void* d_ws, size_t ws_size, hipStream_t stream) {
    static int grid = 0;
    if (grid == 0) {
        if (n_in != 26 || in_sizes[0] != M * DM || out_size != M * DM || ws_size < WS_END) { fprintf(stderr, "kernel_launch: unexpected shapes (n_in %d, in0 %d, out %d, ws %zu)\n", n_in, n_in > 0 ? in_sizes[0] : -1, out_size, ws_size); grid = -1; return; }
        int dev = 0, cus = 0, per_cu = 0;
        if (hipGetDevice(&dev) != hipSuccess || hipDeviceGetAttribute(&cus, hipDeviceAttributeMultiprocessorCount, dev) != hipSuccess) { grid = -1; return; }
        if (hipFuncSetAttribute((const void*)trunk_fwd, hipFuncAttributeMaxDynamicSharedMemorySize, LDS_BYTES) != hipSuccess) { fprintf(stderr, "kernel_launch: hipFuncSetAttribute failed\n"); grid = -1; return; }
        if (hipOccupancyMaxActiveBlocksPerMultiprocessor(&per_cu, (const void*)trunk_fwd, NWAVES * 64, LDS_BYTES) != hipSuccess || per_cu < 1) fprintf(stderr, "kernel_launch: occupancy query reports %d\n", per_cu);
        (void)hipGetLastError();
        grid = cus;
    }
    if (grid < 0) return;
    if (hipMemsetAsync((char*)d_ws + WS_CTL, 0, CTL_ZERO_BYTES, stream) != hipSuccess) return;
    Args a{};
    a.x = (const float*)d_in[0]; a.mem = (const float*)d_in[1]; a.pos = (const int*)d_in[2];
    a.g_mix_pre = (const float*)d_in[3]; a.g_mix_post = (const float*)d_in[4]; a.w_in = (const float*)d_in[5]; a.b_f = (const float*)d_in[6];
    a.lam_q1 = (const float*)d_in[7]; a.lam_k1 = (const float*)d_in[8]; a.lam_q2 = (const float*)d_in[9]; a.lam_k2 = (const float*)d_in[10];
    a.g_diff_sub = (const float*)d_in[11]; a.g_sb_out = (const float*)d_in[12]; a.g_fox_out = (const float*)d_in[13]; a.w_out = (const float*)d_in[14];
    a.g_x_pre = (const float*)d_in[15]; a.g_x_post = (const float*)d_in[16]; a.g_mem = (const float*)d_in[17]; a.w_cq = (const float*)d_in[18]; a.w_ckv = (const float*)d_in[19]; a.w_co = (const float*)d_in[20];
    a.g_ffn_pre = (const float*)d_in[21]; a.g_ffn_post = (const float*)d_in[22]; a.w_gate = (const float*)d_in[23]; a.w_up = (const float*)d_in[24]; a.w_down = (const float*)d_in[25];
    a.out = (float*)d_out; a.ws = (unsigned char*)d_ws;
#if MK_ONE_LAUNCH
#if defined(PROBE_PRE_HI)
    a.ph_lo = 0; a.ph_hi = PROBE_PRE_HI; a.li = 1;
    hipLaunchKernelGGL(trunk_fwd, dim3(grid), dim3(NWAVES * 64), LDS_BYTES, stream, a); (void)hipMemsetAsync((char*)d_ws + WS_CTL, 0, CTL_ZERO_BYTES, stream);
#endif
    a.ph_lo = 0; a.ph_hi = N_PHASES; a.li = 0;
    hipLaunchKernelGGL(trunk_fwd, dim3(grid), dim3(NWAVES * 64), LDS_BYTES, stream, a);
#if defined(PROBE_POST_HI)
    (void)hipMemsetAsync((char*)d_ws + WS_CTL, 0, CTL_ZERO_BYTES, stream); a.ph_lo = 0; a.ph_hi = PROBE_POST_HI; a.li = 1;
    hipLaunchKernelGGL(trunk_fwd, dim3(grid), dim3(NWAVES * 64), LDS_BYTES, stream, a);
#endif
#if defined(PROBE_PRE_HI)
#endif
#else
    for (int p = 0; p < N_PHASES; ++p) { a.ph_lo = p; a.ph_hi = p + 1; a.li = p;
        hipLaunchKernelGGL(trunk_fwd, dim3(grid), dim3(NWAVES * 64), LDS_BYTES, stream, a); }
#endif
}
```
